# Optimizing an MI355X kernel written in HIP

```python
import math
import jax
import jax.numpy as jnp
from jax import lax
import numpy as np

D_MODEL = 1024
BATCH = 16
SEQ = 2048
DEPTH = 4

CTX_LEN = 256
GRID_W = 64
N_MIXERS = 2
N_ATTN_LAYERS = (DEPTH + 1) // 2
N_SSM_LAYERS = DEPTH // 2
DIFF_HEADS = 8
DIFF_HEAD_DIM = D_MODEL // DIFF_HEADS // 2
DIFF_V_DIM = 2 * DIFF_HEAD_DIM
Q_BLOCK = 128
ROPE_BASE = 10000.0
ROPE_F = DIFF_HEAD_DIM // 4
SSM_GROUP = 16
SSM_GROUPS = D_MODEL // SSM_GROUP
SSM_STATE = 64
SSM_CHUNK = 128
SSM_DIRS = 2
DT_MIN = 0.001
DT_MAX = 0.1
N_EXPERTS = 16
EXPERT_FF = 2 * D_MODEL
EC_CAPACITY_FACTOR = 2
N_MOD = 6
EPS = 1e-6

kernel_name = 'hybrid_diffattn_s5_ecmoe_dit'


def rmsnorm(x, g):
    xf = x.astype(jnp.float32)
    y = xf * lax.rsqrt(jnp.mean(xf * xf, axis=-1, keepdims=True) + EPS)
    return (y * g.astype(jnp.float32)).astype(x.dtype)


def modulate(x, shift, scale):
    return x * (1 + scale) + shift


def axial_rope_tables(rows):
    row = jnp.repeat(jnp.arange(rows, dtype=jnp.float32), GRID_W)
    col = jnp.tile(jnp.arange(GRID_W, dtype=jnp.float32), rows)
    inv = ROPE_BASE ** (-jnp.arange(ROPE_F, dtype=jnp.float32) / ROPE_F)
    ang = jnp.stack([row[:, None] * inv, col[:, None] * inv], axis=1)
    return jnp.cos(ang), jnp.sin(ang)


def apply_axial_rope(x, cos, sin):
    shp = x.shape
    xr = x.astype(jnp.float32).reshape(*shp[:-1], 2, 2, ROPE_F)
    x0, x1 = xr[..., 0, :], xr[..., 1, :]
    cs = cos[None, :, None, None]
    sn = sin[None, :, None, None]
    out = jnp.stack([x0 * cs - x1 * sn, x0 * sn + x1 * cs], axis=-2)
    return out.reshape(shp).astype(x.dtype)


def diff_attention(h_lat, h_ctx, w_qkv, w_o, lq1, lk1, lq2, lk2, subln_g, lam_init, cos, sin, with_ctx_out):
    B, L, _ = h_lat.shape
    H, d, dv = DIFF_HEADS, DIFF_HEAD_DIM, DIFF_V_DIM

    def project(h):
        n = h.shape[1]
        q, k, v = jnp.split(h @ w_qkv, 3, axis=-1)
        return q.reshape(B, n, H, 2, d), k.reshape(B, n, H, 2, d), v.reshape(B, n, H, dv)

    q_l, k_l, v_l = project(h_lat)
    q_c, k_c, v_c = project(h_ctx)
    q_l = apply_axial_rope(q_l, cos, sin)
    k_l = apply_axial_rope(k_l, cos, sin)
    f32 = jnp.float32
    lam = (jnp.exp(jnp.sum(lq1.astype(f32) * lk1.astype(f32)))
           - jnp.exp(jnp.sum(lq2.astype(f32) * lk2.astype(f32))) + lam_init)
    scale = d ** -0.5

    def diff_attend(q, k, v):
        s = jnp.einsum('bqhcd,bkhcd->bhcqk', q, k).astype(f32) * scale
        p = jax.nn.softmax(s, axis=-1)
        a = p[:, :, 0] - lam * p[:, :, 1]
        return jnp.einsum('bhqk,bkhe->bqhe', a.astype(v.dtype), v)

    k_all = jnp.concatenate([k_l, k_c], axis=1)
    v_all = jnp.concatenate([v_l, v_c], axis=1)
    nb = L // Q_BLOCK
    q_blocks = q_l.reshape(B, nb, Q_BLOCK, H, 2, d).transpose(1, 0, 2, 3, 4, 5)
    o_l = lax.map(lambda qb: diff_attend(qb, k_all, v_all), q_blocks)
    o_l = o_l.transpose(1, 0, 2, 3, 4).reshape(B, L, H, dv)

    def finish(o):
        o = rmsnorm(o, subln_g) * (1.0 - lam_init)
        return o.reshape(o.shape[0], o.shape[1], H * dv) @ w_o

    out_l = finish(o_l)
    out_c = finish(diff_attend(q_c, k_c, v_c)) if with_ctx_out else None
    return out_l, out_c


def s5_combine(e1, e2):
    a1r, a1i, b1r, b1i = e1
    a2r, a2i, b2r, b2i = e2
    return (a2r * a1r - a2i * a1i, a2r * a1i + a2i * a1r,
            a2r * b1r - a2i * b1i + b2r, a2r * b1i + a2i * b1r + b2i)


def s5_scan(u, lam_re, lam_im, log_dt, b_re, b_im, c_re, c_im, h_re, h_im):
    f32 = jnp.float32
    lam_re, lam_im = lam_re.astype(f32), lam_im.astype(f32)
    b_re, b_im = b_re.astype(f32), b_im.astype(f32)
    c_re, c_im = c_re.astype(f32), c_im.astype(f32)
    dt = jnp.exp(log_dt.astype(f32))[:, None]
    mag = jnp.exp(lam_re * dt)
    ang = lam_im * dt
    ab_re, ab_im = mag * jnp.cos(ang), mag * jnp.sin(ang)
    den = lam_re * lam_re + lam_im * lam_im
    nr, ni = ab_re - 1.0, ab_im
    coef_re = (nr * lam_re + ni * lam_im) / den
    coef_im = (ni * lam_re - nr * lam_im) / den
    bb_re = coef_re[..., None] * b_re - coef_im[..., None] * b_im
    bb_im = coef_re[..., None] * b_im + coef_im[..., None] * b_re
    B, T, G, P = u.shape
    nc = T // SSM_CHUNK
    u_chunks = u.reshape(B, nc, SSM_CHUNK, G, P).transpose(1, 2, 0, 3, 4)

    def chunk_step(carry, u_blk):
        s_re, s_im = carry
        bu_re = jnp.einsum('tbgp,gnp->tbgn', u_blk, bb_re)
        bu_im = jnp.einsum('tbgp,gnp->tbgn', u_blk, bb_im)
        bu_re = bu_re.at[0].add(ab_re * s_re - ab_im * s_im)
        bu_im = bu_im.at[0].add(ab_re * s_im + ab_im * s_re)
        a_re = jnp.broadcast_to(ab_re, bu_re.shape)
        a_im = jnp.broadcast_to(ab_im, bu_im.shape)
        _, _, x_re, x_im = lax.associative_scan(s5_combine, (a_re, a_im, bu_re, bu_im), axis=0)
        y = jnp.einsum('tbgn,gpn->tbgp', x_re, c_re) - jnp.einsum('tbgn,gpn->tbgp', x_im, c_im)
        return (x_re[-1], x_im[-1]), y

    (s_re, s_im), y = lax.scan(chunk_step, (h_re, h_im), u_chunks)
    y = y.transpose(2, 0, 1, 3, 4).reshape(B, T, G, P)
    return y, s_re, s_im


def s5_mixer(h_lat, h_ctx, lam_re, lam_im, log_dt, b_re, b_im, c_re, c_im, d_skip, w_glu1, w_glu2, with_ctx_out):
    B, L, Dm = h_lat.shape
    Lc = h_ctx.shape[1]
    G, P, N = SSM_GROUPS, SSM_GROUP, SSM_STATE
    f32 = jnp.float32
    u_l = h_lat.astype(f32).reshape(B, L, G, P)
    u_c = h_ctx.astype(f32).reshape(B, Lc, G, P)
    dsk = d_skip.astype(f32).reshape(G, P)
    y_l = dsk * u_l
    y_c = dsk * u_c if with_ctx_out else None
    zeros = jnp.zeros((B, G, N), f32)
    for direction in range(SSM_DIRS):
        prm = (lam_re[direction], lam_im[direction], log_dt[direction],
               b_re[direction], b_im[direction], c_re[direction], c_im[direction])
        uc = u_c if direction == 0 else u_c[:, ::-1]
        ul = u_l if direction == 0 else u_l[:, ::-1]
        yc, s_re, s_im = s5_scan(uc, *prm, zeros, zeros)
        yl, _, _ = s5_scan(ul, *prm, s_re, s_im)
        if direction == 1:
            yc, yl = yc[:, ::-1], yl[:, ::-1]
        y_l = y_l + yl
        if with_ctx_out:
            y_c = y_c + yc

    def glu(y, n):
        g = jax.nn.gelu(y.reshape(B, n, Dm)).astype(h_lat.dtype)
        return (g @ w_glu1) * jax.nn.sigmoid(g @ w_glu2)

    out_l = glu(y_l, L)
    out_c = glu(y_c, Lc) if with_ctx_out else None
    return out_l, out_c


def ec_moe(h, w_router, b_router, w_gate, w_up, w_down):
    B, n, Dm = h.shape
    cap = EC_CAPACITY_FACTOR * n // N_EXPERTS
    logits = (h @ w_router + b_router).astype(jnp.float32)
    affinity = jax.nn.softmax(logits, axis=-1)
    weight, idx = lax.top_k(jnp.swapaxes(affinity, 1, 2), cap)
    xin = jax.vmap(lambda hb, ib: hb[ib])(h, idx)
    hid = jax.nn.silu(jnp.einsum('becd,edf->becf', xin, w_gate)) * jnp.einsum('becd,edf->becf', xin, w_up)
    yout = jnp.einsum('becf,efd->becd', hid, w_down) * weight[..., None].astype(h.dtype)

    def scatter_one(ib, yb):
        return jnp.zeros((n, Dm), yb.dtype).at[ib.reshape(-1)].add(yb.reshape(-1, Dm))

    return jax.vmap(scatter_one)(idx, yout)


def setup_inputs(seed: int = 0) -> dict:
    key = jax.random.key(seed)
    ks = iter(jax.random.split(key, 40))

    def nrm(shape, s):
        return jax.random.normal(next(ks), shape, jnp.float32) * s

    D, E, F = D_MODEL, N_EXPERTS, EXPERT_FF
    G, P, N = SSM_GROUPS, SSM_GROUP, SSM_STATE
    NA, NS = N_ATTN_LAYERS, N_SSM_LAYERS
    x = nrm((BATCH, SEQ, D), 1.0)
    c = nrm((BATCH, D), 1.0)
    ctx = nrm((BATCH, CTX_LEN, D), 1.0)
    c_ctx = nrm((D,), 1.0)
    ada_w = nrm((DEPTH, D, N_MOD * D), 0.5 * D ** -0.5)
    ada_b = nrm((DEPTH, N_MOD * D), 0.02)
    norm1_g = 1.0 + nrm((DEPTH, D), 0.01)
    norm2_g = 1.0 + nrm((DEPTH, D), 0.01)
    final_g = 1.0 + nrm((D,), 0.01)
    attn_w_qkv = nrm((NA, D, 3 * D), D ** -0.5)
    attn_w_o = nrm((NA, D, D), D ** -0.5)
    attn_lam_q1 = nrm((NA, DIFF_HEAD_DIM), 0.1)
    attn_lam_k1 = nrm((NA, DIFF_HEAD_DIM), 0.1)
    attn_lam_q2 = nrm((NA, DIFF_HEAD_DIM), 0.1)
    attn_lam_k2 = nrm((NA, DIFF_HEAD_DIM), 0.1)
    attn_subln_g = 1.0 + nrm((NA, DIFF_V_DIM), 0.01)
    ssm_lam_re = -0.5 + nrm((NS, SSM_DIRS, G, N), 0.01)
    ssm_lam_im = math.pi * jnp.arange(N, dtype=jnp.float32) + nrm((NS, SSM_DIRS, G, N), 0.01)
    ssm_log_dt = jax.random.uniform(next(ks), (NS, SSM_DIRS, G), jnp.float32,
                                    math.log(DT_MIN), math.log(DT_MAX))
    ssm_b_re = nrm((NS, SSM_DIRS, G, N, P), (2 * P) ** -0.5)
    ssm_b_im = nrm((NS, SSM_DIRS, G, N, P), (2 * P) ** -0.5)
    ssm_c_re = nrm((NS, SSM_DIRS, G, P, N), (2 * N) ** -0.5)
    ssm_c_im = nrm((NS, SSM_DIRS, G, P, N), (2 * N) ** -0.5)
    ssm_d = 1.0 + nrm((NS, D), 0.1)
    ssm_w_glu1 = nrm((NS, D, D), D ** -0.5)
    ssm_w_glu2 = nrm((NS, D, D), D ** -0.5)
    moe_w_router = nrm((DEPTH, D, E), D ** -0.5)
    moe_b_router = nrm((DEPTH, E), 0.01)
    moe_w_gate = nrm((DEPTH, E, D, F), D ** -0.5)
    moe_w_up = nrm((DEPTH, E, D, F), D ** -0.5)
    moe_w_down = nrm((DEPTH, E, F, D), F ** -0.5)
    return {'x': x, 'c': c, 'ctx': ctx, 'c_ctx': c_ctx,
            'ada_w': ada_w, 'ada_b': ada_b, 'norm1_g': norm1_g, 'norm2_g': norm2_g, 'final_g': final_g,
            'attn_w_qkv': attn_w_qkv, 'attn_w_o': attn_w_o,
            'attn_lam_q1': attn_lam_q1, 'attn_lam_k1': attn_lam_k1,
            'attn_lam_q2': attn_lam_q2, 'attn_lam_k2': attn_lam_k2, 'attn_subln_g': attn_subln_g,
            'ssm_lam_re': ssm_lam_re, 'ssm_lam_im': ssm_lam_im, 'ssm_log_dt': ssm_log_dt,
            'ssm_b_re': ssm_b_re, 'ssm_b_im': ssm_b_im, 'ssm_c_re': ssm_c_re, 'ssm_c_im': ssm_c_im,
            'ssm_d': ssm_d, 'ssm_w_glu1': ssm_w_glu1, 'ssm_w_glu2': ssm_w_glu2,
            'moe_w_router': moe_w_router, 'moe_b_router': moe_b_router,
            'moe_w_gate': moe_w_gate, 'moe_w_up': moe_w_up, 'moe_w_down': moe_w_down}


def reference(x, c, ctx, c_ctx, ada_w, ada_b, norm1_g, norm2_g, final_g,
              attn_w_qkv, attn_w_o, attn_lam_q1, attn_lam_k1, attn_lam_q2, attn_lam_k2, attn_subln_g,
              ssm_lam_re, ssm_lam_im, ssm_log_dt, ssm_b_re, ssm_b_im, ssm_c_re, ssm_c_im,
              ssm_d, ssm_w_glu1, ssm_w_glu2,
              moe_w_router, moe_b_router, moe_w_gate, moe_w_up, moe_w_down):
    B, L, Dm = x.shape
    rows = L // GRID_W
    cos, sin = axial_rope_tables(rows)
    sc_lat = jax.nn.silu(c)
    sc_ctx = jax.nn.silu(c_ctx)
    for i in range(DEPTH):
        with_ctx_out = i < DEPTH - 1
        j = i // N_MIXERS
        mod_l = (sc_lat @ ada_w[i] + ada_b[i])[:, None, :]
        mod_c = sc_ctx @ ada_w[i] + ada_b[i]
        sh1_l, sc1_l, g1_l, sh2_l, sc2_l, g2_l = jnp.split(mod_l, N_MOD, axis=-1)
        sh1_c, sc1_c, g1_c, sh2_c, sc2_c, g2_c = jnp.split(mod_c, N_MOD, axis=-1)
        h_l = modulate(rmsnorm(x, norm1_g[i]), sh1_l, sc1_l)
        h_c = modulate(rmsnorm(ctx, norm1_g[i]), sh1_c, sc1_c)
        if i % N_MIXERS == 0:
            lam_init = 0.8 - 0.6 * math.exp(-0.3 * i)
            o_l, o_c = diff_attention(h_l, h_c, attn_w_qkv[j], attn_w_o[j], attn_lam_q1[j], attn_lam_k1[j],
                                      attn_lam_q2[j], attn_lam_k2[j], attn_subln_g[j], lam_init,
                                      cos, sin, with_ctx_out)
        else:
            o_l, o_c = s5_mixer(h_l, h_c, ssm_lam_re[j], ssm_lam_im[j], ssm_log_dt[j], ssm_b_re[j], ssm_b_im[j],
                                ssm_c_re[j], ssm_c_im[j], ssm_d[j], ssm_w_glu1[j], ssm_w_glu2[j], with_ctx_out)
        x = x + g1_l * o_l
        h_l = modulate(rmsnorm(x, norm2_g[i]), sh2_l, sc2_l)
        x = x + g2_l * ec_moe(h_l, moe_w_router[i], moe_b_router[i], moe_w_gate[i], moe_w_up[i], moe_w_down[i])
        if with_ctx_out:
            ctx = ctx + g1_c * o_c
            h_c = modulate(rmsnorm(ctx, norm2_g[i]), sh2_c, sc2_c)
            ctx = ctx + g2_c * ec_moe(h_c, moe_w_router[i], moe_b_router[i], moe_w_gate[i], moe_w_up[i], moe_w_down[i])
    return rmsnorm(x, final_g)
```

```cpp
#include <hip/hip_runtime.h>
#include <cstdio>
#include <cstdint>

#ifndef ONE_LAUNCH
#define ONE_LAUNCH 1
#endif
#ifndef WO_FP8
#define WO_FP8 0
#endif
#ifndef GLU_FP8
#define GLU_FP8 1
#endif
#ifndef MOE2_FP8
#define MOE2_FP8 1
#endif

#define LAS __attribute__((address_space(3)))
typedef unsigned short bf16_t;
typedef short bf16x8 __attribute__((ext_vector_type(8)));
typedef short s16x4 __attribute__((ext_vector_type(4)));
typedef float f32x4 __attribute__((ext_vector_type(4)));
typedef float f32x2 __attribute__((ext_vector_type(2)));
typedef float f32x16 __attribute__((ext_vector_type(16)));
typedef unsigned u32x4 __attribute__((ext_vector_type(4)));
typedef unsigned u32x2 __attribute__((ext_vector_type(2)));
typedef int i32x8 __attribute__((ext_vector_type(8)));

constexpr int D = 1024, NB = 16, SEQ = 2048, LC = 256, NLAT = NB * SEQ, NCTX = NB * LC, NTOK = NLAT + NCTX;
constexpr int NE = 16, FF = 2048, EROWS = 4608, NMOD = 6 * D;
constexpr float EPS = 1e-6f;

constexpr size_t al256(size_t x) { return (x + 255) / 256 * 256; }
constexpr size_t WS_CTL = 0;
constexpr size_t WS_MOD = 65536;
constexpr size_t WS_ROPE = WS_MOD + al256((size_t)4 * 17 * NMOD * 4);
constexpr size_t WS_S5BB = WS_ROPE + (size_t)2048 * 32 * 2 * 4;
constexpr size_t WS_S5CT = WS_S5BB + (size_t)256 * 4096;
constexpr size_t WS_S5AB = WS_S5CT + (size_t)256 * 4096;
constexpr size_t WS_LAM = WS_S5AB + (size_t)256 * 64 * 2 * 4;
constexpr size_t WS_AFF = WS_LAM + 256;
constexpr size_t WS_SEL = WS_AFF + (size_t)NTOK * 16 * 4;
constexpr size_t WS_MIDX = WS_SEL + (size_t)NTOK * 16 * 4;
constexpr size_t WS_X = WS_MIDX + al256((size_t)NE * EROWS * 4);
constexpr size_t WS_H = WS_X + (size_t)NTOK * D * 4;
constexpr size_t WS_H2 = WS_H + (size_t)NTOK * D * 2;
constexpr size_t WS_AO = WS_H2 + (size_t)NTOK * D * 2;
constexpr size_t WS_BIG = WS_AO + (size_t)NTOK * D * 2;
constexpr size_t WS_Y = WS_BIG + (size_t)NE * EROWS * FF * 2;
constexpr size_t WS_WQKV = WS_Y + (size_t)NE * EROWS * D * 2;
constexpr size_t WS_WO = WS_WQKV + (size_t)2 * 3072 * D * 2;
constexpr size_t WS_WGLU = WS_WO + (size_t)2 * D * D * 2;
constexpr size_t WS_WGU = WS_WGLU + (size_t)2 * 2048 * D * 2;
constexpr size_t WS_WD = WS_WGU + (size_t)64 * 4096 * D * 2;
constexpr size_t WS_H2Q = WS_WD + (size_t)64 * D * FF * 2;
constexpr size_t WS_SH = WS_H2Q + (size_t)NTOK * D;
constexpr size_t WS_END = WS_SH + (size_t)NTOK * 4;
constexpr size_t WS_S5T3 = WS_WGU + (size_t)64 * 4096 * D;
constexpr size_t WS_S5T1 = WS_S5T3 + (size_t)128 * 262144;
static_assert(WS_S5T1 + (size_t)128 * 131072 <= WS_WD, "S5 tables fit");
static_assert((size_t)NTOK * 3072 * 2 <= (size_t)NE * EROWS * FF * 2, "QKV fits BIG");
static_assert((size_t)1024 * 2304 * 16 * 4 <= (size_t)NE * EROWS * FF * 2, "SP fits BIG");

constexpr int LDS_BYTES = 163840;
constexpr int LDS_SCR = 1024;

#define XB_TMO      128
#define XB_XCNT(j)  (256  + 64 * (j))
#define XB_XSUB(j)  (1280 + 64 * (j))
#define XB_XGEN(j)  (2304 + 64 * (j))
#define XB_TOP      3328
#define XB_TOPGEN   3392
#define XCD_BAR_WORDS 3456
#define XB_SPIN_CAP (1u << 18)

__device__ __forceinline__ unsigned xb_ld(unsigned* p)              { return __hip_atomic_load(p, __ATOMIC_RELAXED, __HIP_MEMORY_SCOPE_AGENT); }
__device__ __forceinline__ unsigned xb_add(unsigned* p, unsigned v) { return __hip_atomic_fetch_add(p, v, __ATOMIC_RELAXED, __HIP_MEMORY_SCOPE_AGENT); }
__device__ __forceinline__ unsigned xb_xcc_id() { return (unsigned)__builtin_amdgcn_s_getreg((3 << 11) | 20) & 0xFu; }
#define XB_SPIN(cond, bar) do { unsigned _sp = 0; while (cond) { __builtin_amdgcn_s_sleep(1); \
    if ((++_sp & 255u) == 0u) { if (xb_ld(&(bar)[XB_TMO])) break; if (_sp > XB_SPIN_CAP) { atomicAdd(&(bar)[XB_TMO], 1u); break; } } } } while (0)

struct XcdBarrier { unsigned* bar; unsigned x; volatile LAS unsigned* st; };

__device__ __forceinline__ XcdBarrier xcd_barrier_post(unsigned* bar, volatile LAS unsigned* st) {
    XcdBarrier b; b.bar = bar; b.x = xb_xcc_id(); b.st = st;
    if (threadIdx.x == 0) (void)xb_add(&bar[XB_XCNT(b.x)], 1u);
    return b;
}
__device__ __forceinline__ void xcd_barrier_complete(unsigned* bar, unsigned x, unsigned& nloc, unsigned& nx) {
    const unsigned G = gridDim.x * gridDim.y * gridDim.z;
    unsigned sum, cnt, mine, sp = 0u;
    for (;;) {
        sum = 0u; cnt = 0u; mine = 0u;
#pragma unroll
        for (unsigned j = 0; j < 16; ++j) { const unsigned c = xb_ld(&bar[XB_XCNT(j)]); sum += c; cnt += (c > 0u) ? 1u : 0u; mine = (j == x) ? c : mine; }
        if (sum == G) break;
        __builtin_amdgcn_s_sleep(1);
        if ((++sp & 255u) == 0u) { if (xb_ld(&bar[XB_TMO])) break; if (sp > XB_SPIN_CAP) { atomicAdd(&bar[XB_TMO], 1u); break; } }
    }
    nloc = mine > 0u ? mine : 1u; nx = cnt > 0u ? cnt : 1u;
}
__device__ __forceinline__ void xcd_barrier(const XcdBarrier& b) {
    asm volatile("s_waitcnt vmcnt(0)" ::: "memory");
    __syncthreads();
    if (threadIdx.x == 0) {
        unsigned* bar = b.bar;
        __builtin_amdgcn_s_waitcnt(0);
        unsigned nloc = b.st[0], nx = b.st[1];
        if (nloc == 0u) { xcd_barrier_complete(bar, b.x, nloc, nx); b.st[0] = nloc; b.st[1] = nx; }
        const unsigned old = xb_add(&bar[XB_XSUB(b.x)], 1u);
        const unsigned gen = old / nloc;
        if (old + 1u == (gen + 1u) * nloc) {
            __builtin_amdgcn_fence(__ATOMIC_RELEASE, "agent");
            asm volatile("s_waitcnt vmcnt(0)" ::: "memory");
            const unsigned og = xb_add(&bar[XB_TOP], 1u);
            const unsigned tg = og / nx;
            if (og + 1u == (tg + 1u) * nx) xb_add(&bar[XB_TOPGEN], 1u);
            else XB_SPIN(xb_ld(&bar[XB_TOPGEN]) == tg, bar);
            __builtin_amdgcn_fence(__ATOMIC_ACQUIRE, "agent");
            xb_add(&bar[XB_XGEN(b.x)], 1u);
            asm volatile("s_waitcnt vmcnt(0)" ::: "memory");
        } else {
            XB_SPIN(xb_ld(&bar[XB_XGEN(b.x)]) == gen, bar);
            __builtin_amdgcn_fence(__ATOMIC_ACQUIRE, "agent");
            asm volatile("s_waitcnt vmcnt(0)" ::: "memory");
        }
    }
    __syncthreads();
}

__device__ __forceinline__ unsigned cvt_pk_bf16(float lo, float hi) { unsigned r; asm volatile("v_cvt_pk_bf16_f32 %0, %1, %2" : "=v"(r) : "v"(lo), "v"(hi)); return r; }
constexpr float W8_SCALE = 2048.0f, W8_INV = 1.0f / 2048.0f;
constexpr float HID8_SCALE = 16.0f, HID8_INV = 1.0f / 16.0f;
constexpr float QSCALE = 0.125f * 1.4426950408889634f;
constexpr float Y8_SCALE = 64.0f, Y8_INV = 1.0f / 64.0f;
constexpr float A8_SCALE = 16.0f, A8_INV = 1.0f / 16.0f;
constexpr float H8_SCALE = 16.0f, H8_INV = 1.0f / 16.0f;
__device__ __forceinline__ float clamp448(float x) { return __builtin_amdgcn_fmed3f(x, -448.0f, 448.0f); }
__device__ __forceinline__ unsigned pk4_fp8(float a, float b, float c, float d) {
    int p = __builtin_amdgcn_cvt_pk_fp8_f32(clamp448(a), clamp448(b), 0, false);
    p = __builtin_amdgcn_cvt_pk_fp8_f32(clamp448(c), clamp448(d), p, true);
    return (unsigned)p;
}
__device__ __forceinline__ float bf_lo(unsigned w) { return __uint_as_float(w << 16); }
__device__ __forceinline__ float bf_hi(unsigned w) { return __uint_as_float(w & 0xffff0000u); }
__device__ __forceinline__ f32x4 bf4_unpack(u32x2 t) { return (f32x4){bf_lo(t.x), bf_hi(t.x), bf_lo(t.y), bf_hi(t.y)}; }
__device__ __forceinline__ u32x2 bf4_pack(f32x4 v) { u32x2 o; o.x = cvt_pk_bf16(v[0], v[1]); o.y = cvt_pk_bf16(v[2], v[3]); return o; }
__device__ __forceinline__ float wave_sum(float v) {
#pragma unroll
    for (int o = 32; o > 0; o >>= 1) v += __shfl_xor(v, o);
    return v;
}
__device__ __forceinline__ float sigmoidf_(float x) { return __builtin_amdgcn_rcpf(1.0f + __builtin_amdgcn_exp2f(x * -1.4426950408889634f)); }
__device__ __forceinline__ float siluf_(float x) { return x * sigmoidf_(x); }
__device__ __forceinline__ float gelu_tanh(float y) {
    const float z = y * fmaf(y * y, -0.10294324f, -2.3022082f); return y * __builtin_amdgcn_rcpf(1.0f + __builtin_amdgcn_exp2f(z)); }

struct Args { const float* in[31]; float* out; unsigned char* ws; int ph_lo, ph_hi; };

struct Ctx {
    const float* const* in; float* out; unsigned char* ws; LAS unsigned char* lds;
    int tid, lane, wave, blk, G, vcu;
    int split, conv, cblk, cG, vblk, vG;
    __device__ __forceinline__ float* mod() const { return (float*)(ws + WS_MOD); }
    __device__ __forceinline__ bf16_t* XB() const { return (bf16_t*)(ws + WS_X); }
    __device__ __forceinline__ bf16_t* H() const { return (bf16_t*)(ws + WS_H); }
    __device__ __forceinline__ bf16_t* H2() const { return (bf16_t*)(ws + WS_H2); }
    __device__ __forceinline__ bf16_t* AO() const { return (bf16_t*)(ws + WS_AO); }
    __device__ __forceinline__ bf16_t* QKV() const { return (bf16_t*)(ws + WS_BIG); }
    __device__ __forceinline__ bf16_t* HID() const { return (bf16_t*)(ws + WS_BIG); }
    __device__ __forceinline__ float* SP() const { return (float*)(ws + WS_BIG); }
    __device__ __forceinline__ bf16_t* Y() const { return (bf16_t*)(ws + WS_Y); }
    __device__ __forceinline__ float* AFF() const { return (float*)(ws + WS_AFF); }
    __device__ __forceinline__ int* SEL() const { return (int*)(ws + WS_SEL); }
    __device__ __forceinline__ int* MIDX() const { return (int*)(ws + WS_MIDX); }
    __device__ __forceinline__ unsigned char* H2Q() const { return ws + WS_H2Q; }
    __device__ __forceinline__ float* SH() const { return (float*)(ws + WS_SH); }
    __device__ __forceinline__ unsigned char* HID8() const { return ws + WS_BIG; }
};

__device__ __forceinline__ int qkv_colmap(int r) {
    if (r >= 2048) return r;
    const int sec = r >> 10, rr = r & 1023, hc = rr >> 6, jn = rr & 63, pr = jn >> 1, half = jn & 1, a = pr >> 4, f = pr & 15;
    return sec * 1024 + hc * 64 + a * 32 + half * 16 + f;
}
constexpr int CV_QKV = 2 * 24 * 8, CV_WO = 2 * 8 * 8, CV_GLU = 2 * 16 * 8, CV_GU = 64 * 32 * 8, CV_D = 64 * 8 * 16;
constexpr int CV_TOTAL = CV_QKV + CV_WO + CV_GLU + CV_GU + CV_D;


__device__ __forceinline__ void p_convert_fp8(const Ctx& F, const int first, const int stride, const int n_lo, const int n_hi) {
    LAS unsigned* T0 = (LAS unsigned*)(F.lds + LDS_SCR); LAS unsigned* T1 = T0 + 128 * 34;
    const int cg = F.tid & 31, kp = F.tid >> 5;
    const int orow = F.tid >> 2, kq = F.tid & 3;
#define CV8_DECODE(q, SRC, DST, NN, KK, R0, K0, C0) do { \
    if ((q) < CV_GU) { const int ie = (q) / 256, rem = (q) % 256; R0 = (rem >> 3) * 128; K0 = (rem & 7) * 128; NN = 2048; KK = 1024; \
        const int tile = R0 >> 8, half = (R0 >> 7) & 1; C0 = tile * 128; \
        SRC = (half ? F.in[29] : F.in[28]) + (size_t)ie * 1024 * 2048; DST = F.ws + WS_WGU + (size_t)ie * 4096 * 1024; } \
    else { const int qq = (q) - CV_GU, ie = qq / 128, rem = qq % 128; R0 = (rem >> 4) * 128; K0 = (rem & 15) * 128; NN = 1024; KK = 2048; C0 = R0; \
        SRC = F.in[30] + (size_t)ie * 2048 * 1024; DST = F.ws + WS_WD + (size_t)ie * 1024 * 2048; } } while (0)
#define CV8_LOAD(V, q) do { const float* src_; unsigned char* dst_; int N_, K_, r0_, k0_, c0_; CV8_DECODE(q, src_, dst_, N_, K_, r0_, k0_, c0_); (void)dst_; (void)K_; (void)r0_; \
    const float* sp_ = src_ + (size_t)(k0_ + 4 * kp) * N_ + c0_ + 4 * cg; \
    _Pragma("unroll") for (int p = 0; p < 2; ++p) _Pragma("unroll") for (int r = 0; r < 4; ++r) V[p][r] = *(const f32x4*)(sp_ + (size_t)(64 * p + r) * N_); } while (0)
#define CV8_PROC(V, q, TB) do { const float* src_; unsigned char* dst_; int N_, K_, r0_, k0_, c0_; CV8_DECODE(q, src_, dst_, N_, K_, r0_, k0_, c0_); (void)src_; (void)N_; (void)c0_; \
    _Pragma("unroll") for (int p = 0; p < 2; ++p) _Pragma("unroll") for (int c = 0; c < 4; ++c) \
        (TB)[(4 * cg + c) * 34 + kp + 16 * p] = pk4_fp8(V[p][0][c] * W8_SCALE, V[p][1][c] * W8_SCALE, V[p][2][c] * W8_SCALE, V[p][3][c] * W8_SCALE); \
    asm volatile("s_waitcnt lgkmcnt(0)" ::: "memory"); __builtin_amdgcn_s_barrier(); asm volatile("" ::: "memory"); \
    { const LAS u32x2* rp = (const LAS u32x2*)((TB) + orow * 34 + kq * 8); u32x4 o0, o1; u32x2 t0, t1; \
      t0 = rp[0]; t1 = rp[1]; o0.x = t0.x; o0.y = t0.y; o0.z = t1.x; o0.w = t1.y; \
      t0 = rp[2]; t1 = rp[3]; o1.x = t0.x; o1.y = t0.y; o1.z = t1.x; o1.w = t1.y; \
      u32x4* dp = (u32x4*)(dst_ + (size_t)(r0_ + orow) * K_ + k0_ + kq * 32); dp[0] = o0; dp[1] = o1; } } while (0)
    LAS unsigned* T2 = T1 + 128 * 34;
    f32x4 vA[2][4], vB[2][4], vC[2][4];
    if (n_lo < n_hi) CV8_LOAD(vA, first + n_lo * stride);
    if (n_lo + 1 < n_hi) CV8_LOAD(vB, first + (n_lo + 1) * stride);
#pragma unroll 1
    for (int n = n_lo; n < n_hi; n += 3) {
        if (n + 2 < n_hi) CV8_LOAD(vC, first + (n + 2) * stride);
        CV8_PROC(vA, first + n * stride, T0);
        if (n + 1 < n_hi) { if (n + 3 < n_hi) CV8_LOAD(vA, first + (n + 3) * stride); CV8_PROC(vB, first + (n + 1) * stride, T1); }
        if (n + 2 < n_hi) { if (n + 4 < n_hi) CV8_LOAD(vB, first + (n + 4) * stride); CV8_PROC(vC, first + (n + 2) * stride, T2); }
    }
    __syncthreads();
#undef CV8_DECODE
#undef CV8_LOAD
#undef CV8_PROC
}


__device__ __forceinline__ void p_s5tables(const Ctx& F, const int u_first, const int u_stride, const int u_end) {
    LAS float* PW = (LAS float*)(F.lds + LDS_SCR);
    LAS float* BC = PW + 2 * 17 * 64 * 2;
    LAS float* CC = BC + 2 * 64 * 16 * 2;
    LAS float* KL = CC + 2 * 16 * 64 * 2;
    LAS float* CF = KL + 2 * 16 * 16 * 16;
#pragma unroll 1
    for (int unit = u_first; unit < u_end; unit += u_stride) {
        const int it = unit >> 1, half = unit & 1, j2 = it >> 6, g = it & 63;
        __syncthreads();
        if (F.tid < 128) { const int d = F.tid >> 6, n = F.tid & 63, gd = (j2 * 2 + d) * 64 + g, idx = gd * 64 + n;
            const float dt = expf(F.in[18][gd]); const float lr = F.in[16][idx], li = F.in[17][idx];
            const float mag = expf(lr * dt), ang = li * dt; float sn, cs; sincosf(ang, &sn, &cs);
            const float abr = mag * cs, abi = mag * sn, den = lr * lr + li * li, nr = abr - 1.0f, ni = abi;
            CF[(d * 64 + n) * 2] = (nr * lr + ni * li) / den; CF[(d * 64 + n) * 2 + 1] = (ni * lr - nr * li) / den;
            float pr = 1.f, pi = 0.f;
#pragma unroll 1
            for (int k = 0; k < 17; ++k) { PW[((d * 17 + k) * 64 + n) * 2] = pr; PW[((d * 17 + k) * 64 + n) * 2 + 1] = pi; const float tr = pr * abr - pi * abi; pi = pr * abi + pi * abr; pr = tr; }
        }
        __syncthreads();
#pragma unroll 1
        for (int e = F.tid; e < 2048; e += 512) { const int d = e >> 10, gd = (j2 * 2 + d) * 64 + g;
            { const int n = (e >> 4) & 63, p = e & 15; const float cr = CF[(d * 64 + n) * 2], ci = CF[(d * 64 + n) * 2 + 1];
              const float br = F.in[19][((size_t)gd * 64 + n) * 16 + p], bi = F.in[20][((size_t)gd * 64 + n) * 16 + p];
              BC[e * 2] = cr * br - ci * bi; BC[e * 2 + 1] = cr * bi + ci * br; }
            { const int p = (e >> 6) & 15, n = e & 63; CC[e * 2] = F.in[21][(size_t)gd * 1024 + p * 64 + n]; CC[e * 2 + 1] = F.in[22][(size_t)gd * 1024 + p * 64 + n]; } }
        __syncthreads();
        { const int d = F.tid >> 8, k = (F.tid >> 4) & 15, co = F.tid & 15; float acc[16];
#pragma unroll
          for (int ci = 0; ci < 16; ++ci) acc[ci] = 0.f;
#pragma unroll 2
          for (int n = 0; n < 64; ++n) { const float cr = CC[((d * 16 + co) * 64 + n) * 2], cim = CC[((d * 16 + co) * 64 + n) * 2 + 1];
              const float pr = PW[((d * 17 + k) * 64 + n) * 2], pi = PW[((d * 17 + k) * 64 + n) * 2 + 1]; const float zr = cr * pr - cim * pi, zi = cr * pi + cim * pr;
#pragma unroll
              for (int ci = 0; ci < 16; ++ci) acc[ci] += zr * BC[((d * 64 + n) * 16 + ci) * 2] - zi * BC[((d * 64 + n) * 16 + ci) * 2 + 1]; }
#pragma unroll
          for (int ci = 0; ci < 16; ++ci) KL[((d * 16 + k) * 16 + co) * 16 + ci] = acc[ci]; }
        __syncthreads();
        u32x4* t3 = (u32x4*)(F.ws + WS_S5T3 + (size_t)it * 262144);
#pragma unroll 1
        for (int c = half * 8192 + F.tid; c < (half + 1) * 8192; c += 512) {
            const int ln = c & 63, kk = (c >> 6) & 15, tt = (c >> 10) & 1, wv = c >> 11, co = ln & 15, pq = ln >> 4, t = 2 * wv + tt; float v[8];
            if (kk < 8) { const int sq = 2 * kk + (pq >> 1), ci0 = (pq & 1) * 8; const float dsk = F.in[23][j2 * D + g * 16 + co];
#pragma unroll
                for (int e = 0; e < 8; ++e) { const int ci = ci0 + e;
                    v[e] = (sq < t) ? KL[((t - sq) * 16 + co) * 16 + ci] : (sq > t) ? KL[((16 + sq - t) * 16 + co) * 16 + ci] : KL[co * 16 + ci] + KL[(16 * 16 + co) * 16 + ci] + (ci == co ? dsk : 0.f); }
            } else { const int d = kk >= 12 ? 1 : 0, n0 = (((kk - 8) & 3) * 32 + pq * 8) >> 1, pk = d == 0 ? t + 1 : 16 - t;
#pragma unroll
                for (int q = 0; q < 4; ++q) { const int n = n0 + q; const float cr = CC[((d * 16 + co) * 64 + n) * 2], cim = CC[((d * 16 + co) * 64 + n) * 2 + 1];
                    const float pr = PW[((d * 17 + pk) * 64 + n) * 2], pi = PW[((d * 17 + pk) * 64 + n) * 2 + 1]; v[2 * q] = cr * pr - cim * pi; v[2 * q + 1] = -(cr * pi + cim * pr); } }
            u32x4 o; o.x = cvt_pk_bf16(v[0], v[1]); o.y = cvt_pk_bf16(v[2], v[3]); o.z = cvt_pk_bf16(v[4], v[5]); o.w = cvt_pk_bf16(v[6], v[7]); t3[c] = o;
        }
        u32x4* t1 = (u32x4*)(F.ws + WS_S5T1 + (size_t)it * 131072);
#pragma unroll 1
        for (int c = half * 4096 + F.tid; c < (half + 1) * 4096; c += 512) {
            const int ln = c & 63, kk = (c >> 6) & 7, wv = (c >> 9) & 7, d = c >> 12, l16 = ln & 15, pq = ln >> 4;
            const int n = 8 * wv + (l16 >> 1), comp = l16 & 1, sq = 2 * kk + (pq >> 1), ci0 = (pq & 1) * 8, pk = d == 0 ? 15 - sq : sq; float v[8];
            const float pr = PW[((d * 17 + pk) * 64 + n) * 2], pi = PW[((d * 17 + pk) * 64 + n) * 2 + 1];
#pragma unroll
            for (int e = 0; e < 8; ++e) { const float br = BC[((d * 64 + n) * 16 + ci0 + e) * 2], bi = BC[((d * 64 + n) * 16 + ci0 + e) * 2 + 1]; v[e] = comp == 0 ? pr * br - pi * bi : pr * bi + pi * br; }
            u32x4 o; o.x = cvt_pk_bf16(v[0], v[1]); o.y = cvt_pk_bf16(v[2], v[3]); o.z = cvt_pk_bf16(v[4], v[5]); o.w = cvt_pk_bf16(v[6], v[7]); t1[c] = o;
        }
    }
    __syncthreads();
}

__device__ __forceinline__ void p_prologue(const Ctx& F) {
    {
        LAS unsigned* T = (LAS unsigned*)(F.lds + LDS_SCR);
        const int cg = F.tid & 31, kp = F.tid >> 5;
        const int orow = F.tid >> 2, kq = F.tid & 3;
        for (int it = F.blk; it < CV_QKV + CV_WO + CV_GLU; it += F.G) {
            const float* src; bf16_t* dst; int N, K, r0, k0, c0; bool perm = false;
            if (it < CV_QKV) { const int j = it / 192, rem = it % 192; r0 = (rem >> 3) * 128; k0 = (rem & 7) * 128; N = 3072; K = 1024; c0 = r0; perm = r0 < 2048;
                src = F.in[9] + (size_t)j * 1024 * 3072; dst = (bf16_t*)(F.ws + WS_WQKV) + (size_t)j * 3072 * 1024; }
            else if (it < CV_QKV + CV_WO) { const int q = it - CV_QKV, j = q / 64, rem = q % 64; r0 = (rem >> 3) * 128; k0 = (rem & 7) * 128; N = 1024; K = 1024; c0 = r0;
                src = F.in[10] + (size_t)j * 1024 * 1024; dst = (bf16_t*)(F.ws + WS_WO + (size_t)j * 1024 * 1024 * (WO_FP8 ? 1 : 2)); }
            else { const int q = it - CV_QKV - CV_WO, j = q / 128, rem = q % 128; r0 = (rem >> 3) * 128; k0 = (rem & 7) * 128; N = 1024; K = 1024;
                const int tile = r0 >> 8, half = (r0 >> 7) & 1; c0 = tile * 128;
                src = (half ? F.in[25] : F.in[24]) + (size_t)j * 1024 * 1024; dst = (bf16_t*)(F.ws + WS_WGLU + (size_t)j * 2048 * 1024 * (GLU_FP8 ? 1 : 2)); }
            const float wsc = (it < CV_QKV && r0 < 1024) ? QSCALE : 1.0f;
            const float* sp = src + (size_t)(k0 + 2 * kp) * N + c0 + 4 * cg;
            f32x4 va[4], vb[4];
#pragma unroll
            for (int p = 0; p < 4; ++p) { va[p] = *(const f32x4*)(sp + (size_t)(32 * p) * N); vb[p] = *(const f32x4*)(sp + (size_t)(32 * p + 1) * N); }
#pragma unroll
            for (int p = 0; p < 4; ++p)
#pragma unroll
                for (int c = 0; c < 4; ++c) {
                    int lr = 4 * cg + c;
                    if (perm) { const int grp = lr & 64, o = lr & 63, a = o >> 5, half = (o >> 4) & 1, f = o & 15; lr = grp + 2 * (a * 16 + f) + half; }
                    T[lr * 66 + kp + 16 * p] = cvt_pk_bf16(va[p][c] * wsc, vb[p][c] * wsc);
                }
            __syncthreads();
            {
                const LAS u32x2* rp = (const LAS u32x2*)(T + orow * 66 + kq * 16);
                u32x4 o0, o1, o2, o3; u32x2 t0, t1;
                t0 = rp[0]; t1 = rp[1]; o0.x = t0.x; o0.y = t0.y; o0.z = t1.x; o0.w = t1.y;
                t0 = rp[2]; t1 = rp[3]; o1.x = t0.x; o1.y = t0.y; o1.z = t1.x; o1.w = t1.y;
                t0 = rp[4]; t1 = rp[5]; o2.x = t0.x; o2.y = t0.y; o2.z = t1.x; o2.w = t1.y;
                t0 = rp[6]; t1 = rp[7]; o3.x = t0.x; o3.y = t0.y; o3.z = t1.x; o3.w = t1.y;
                if (it < CV_QKV || (!WO_FP8 && it < CV_QKV + CV_WO) || (!GLU_FP8 && it >= CV_QKV + CV_WO)) { u32x4* dp = (u32x4*)(dst + (size_t)(r0 + orow) * K + k0 + kq * 32); dp[0] = o0; dp[1] = o1; dp[2] = o2; dp[3] = o3; }
                else {
#define PK8(w0, w1) pk4_fp8(bf_lo(w0) * W8_SCALE, bf_hi(w0) * W8_SCALE, bf_lo(w1) * W8_SCALE, bf_hi(w1) * W8_SCALE)
                    u32x4 q0, q1; q0.x = PK8(o0.x, o0.y); q0.y = PK8(o0.z, o0.w); q0.z = PK8(o1.x, o1.y); q0.w = PK8(o1.z, o1.w);
                    q1.x = PK8(o2.x, o2.y); q1.y = PK8(o2.z, o2.w); q1.z = PK8(o3.x, o3.y); q1.w = PK8(o3.z, o3.w);
#undef PK8
                    u32x4* dp = (u32x4*)((unsigned char*)dst + (size_t)(r0 + orow) * K + k0 + kq * 32); dp[0] = q0; dp[1] = q1; }
            }
            __syncthreads();
        }
    }
    if (!F.split) p_convert_fp8(F, F.blk, F.G, 0, (CV_GU + CV_D + F.G - 1 - F.blk) / F.G);
    {
        LAS float* sc = (LAS float*)(F.lds + LDS_SCR);
        LAS float* red = sc + 17 * 1024;
        if (F.blk < 192) {
            for (int idx = F.tid; idx < 17 * 1024; idx += 512) { const int s = idx >> 10, k = idx & 1023; const float v = s < 16 ? F.in[1][s * 1024 + k] : F.in[3][k]; sc[idx] = siluf_(v); }
            __syncthreads();
        }
        for (int it = F.blk; it < 192; it += F.G) {
            const int i = it / 48, n0 = (it % 48) * 128, nl = F.tid & 127, kq = F.tid >> 7;
            float acc[17];
#pragma unroll
            for (int s = 0; s < 17; ++s) acc[s] = 0.f;
            const float* wp = F.in[4] + ((size_t)i * 1024 + kq * 256) * NMOD + n0 + nl;
#pragma unroll 2
            for (int k = 0; k < 256; k += 4) {
                const float w0 = wp[(size_t)k * NMOD], w1 = wp[(size_t)(k + 1) * NMOD], w2 = wp[(size_t)(k + 2) * NMOD], w3 = wp[(size_t)(k + 3) * NMOD];
#pragma unroll
                for (int s = 0; s < 17; ++s) { const f32x4 c4 = *(const LAS f32x4*)(sc + s * 1024 + kq * 256 + k);
                    acc[s] += c4[0] * w0 + c4[1] * w1 + c4[2] * w2 + c4[3] * w3; } }
#pragma unroll
            for (int s = 0; s < 17; ++s) red[(kq * 17 + s) * 128 + nl] = acc[s];
            __syncthreads();
            for (int idx = F.tid; idx < 17 * 128; idx += 512) { const int s = idx >> 7, n = idx & 127;
                const float v = red[(0 * 17 + s) * 128 + n] + red[(1 * 17 + s) * 128 + n] + red[(2 * 17 + s) * 128 + n] + red[(3 * 17 + s) * 128 + n] + F.in[5][i * NMOD + n0 + n];
                F.mod()[((size_t)i * 17 + s) * NMOD + n0 + n] = v; }
            __syncthreads();
        }
    }
    for (int idx = F.blk * 512 + F.tid; idx < 2048 * 32; idx += F.G * 512) {
        const int t = idx >> 5, fp = idx & 31, a = fp >> 4, f = fp & 15; const float pos = (float)(a ? (t & 63) : (t >> 6));
        const float inv = powf(10000.0f, -(float)f / 16.0f); const float ang = pos * inv; float s, c; sincosf(ang, &s, &c);
        float* rt = (float*)(F.ws + WS_ROPE); rt[idx * 2] = c; rt[idx * 2 + 1] = s;
    }
    for (int idx = F.blk * 512 + F.tid; idx < 2 * 2 * 64 * 64; idx += F.G * 512) {
        const int n = idx & 63, gd = idx >> 6;
        const float dt = expf(F.in[18][gd]); const float lr = F.in[16][idx], li = F.in[17][idx];
        const float mag = expf(lr * dt), ang = li * dt; float sn, cs; sincosf(ang, &sn, &cs);
        const float abr = mag * cs, abi = mag * sn;
        float* ab = (float*)(F.ws + WS_S5AB); ab[idx * 2] = abr; ab[idx * 2 + 1] = abi;
    }
    if (F.blk == 0 && F.tid < 2) {
        const int j = F.tid; float s1 = 0.f, s2 = 0.f;
        for (int k = 0; k < 64; ++k) { s1 += F.in[11][j * 64 + k] * F.in[12][j * 64 + k]; s2 += F.in[13][j * 64 + k] * F.in[14][j * 64 + k]; }
        const float lam_init = 0.8f - 0.6f * expf(-0.3f * (float)(2 * j));
        float* lv = (float*)(F.ws + WS_LAM); lv[j * 2] = expf(s1) - expf(s2) + lam_init; lv[j * 2 + 1] = 1.0f - lam_init;
    }
    if (!(F.G == 256)) p_s5tables(F, F.blk, F.G, 256);
}

__device__ __forceinline__ void p_rows_R_one(const Ctx& F, const int layer) {
    const int lane = F.lane; const int nrows = (layer == 4) ? NLAT : NTOK;
    const int rpb = (nrows + F.G - 1) / F.G;
    const int r_hi = ((F.blk + 1) * rpb < nrows) ? (F.blk + 1) * rpb : nrows, r_lo = F.blk * rpb + F.wave;
#define R_LOAD(rw) { if (layer == 0) { const float* src = ((rw) < NLAT) ? F.in[0] + (size_t)(rw) * D : F.in[2] + (size_t)((rw) - NLAT) * D; \
        _Pragma("unroll") for (int i = 0; i < 4; ++i) xnx[i] = *(const f32x4*)(src + i * 256 + lane * 4); } \
      else { const bf16_t* src = F.XB() + (size_t)(rw) * D; _Pragma("unroll") for (int i = 0; i < 4; ++i) xnb[i] = *(const u32x2*)(src + i * 256 + lane * 4); } }
    f32x4 xnx[4]; u32x2 xnb[4]; int seln = 0; float affn = 0.f;
#pragma unroll
    for (int i = 0; i < 4; ++i) { xnx[i] = (f32x4){0.f, 0.f, 0.f, 0.f}; xnb[i] = (u32x2){0u, 0u}; }
    if (r_lo < r_hi) { R_LOAD(r_lo)
        if (layer >= 1 && lane < 16) { seln = F.SEL()[(size_t)r_lo * 16 + lane]; affn = F.AFF()[(size_t)r_lo * 16 + lane]; } }
    int s_cur = -1; f32x4 Am[4], Bm[4], g2[4];
#pragma unroll
    for (int i = 0; i < 4; ++i) { Am[i] = (f32x4){0.f, 0.f, 0.f, 0.f}; Bm[i] = Am[i]; g2[i] = Am[i]; }
#pragma unroll 1
    for (int row = r_lo; row < r_hi; row += 8) {
        const bool lat = row < NLAT; const int s = lat ? (row >> 11) : 16;
        f32x4 xv[4];
#pragma unroll
        for (int i = 0; i < 4; ++i) xv[i] = (layer == 0) ? xnx[i] : bf4_unpack(xnb[i]);
        const int selv = seln; const float affv = affn;
        if (s != s_cur) { s_cur = s;
#pragma unroll
            for (int i = 0; i < 4; ++i) { const int c = i * 256 + lane * 4;
                if (layer == 4) { Am[i] = *(const f32x4*)(F.in[8] + c); }
                else { const float* mp = F.mod() + ((size_t)layer * 17 + s) * NMOD; const f32x4 g = *(const f32x4*)(F.in[6] + layer * D + c);
                    Bm[i] = *(const f32x4*)(mp + c); Am[i] = g * (*(const f32x4*)(mp + D + c) + 1.0f); }
                if (layer >= 1) g2[i] = *(const f32x4*)(F.mod() + ((size_t)(layer - 1) * 17 + s) * NMOD + 5 * D + c); }
#pragma unroll
            for (int i = 0; i < 4; ++i) asm volatile("" : "+v"(Am[i]), "+v"(Bm[i]), "+v"(g2[i]));
        }
        if (row + 8 < r_hi) { R_LOAD(row + 8)
            if (layer >= 1 && lane < 16) { seln = F.SEL()[(size_t)(row + 8) * 16 + lane]; affn = F.AFF()[(size_t)(row + 8) * 16 + lane]; } }
        if (layer >= 1) {
            const int pbase = lat ? ((row >> 11) * 256) : (4096 + ((row - NLAT) >> 8) * 32);
#pragma unroll
            for (int e = 0; e < 16; ++e) {
                const int slot = __builtin_amdgcn_readlane(selv, e);
                if (slot >= 0) {
                    const float w = __uint_as_float(__builtin_amdgcn_readlane(__float_as_uint(affv), e)) * Y8_INV;
                    const unsigned char* yp = (const unsigned char*)F.Y() + ((size_t)e * EROWS + pbase + slot) * D + lane * 4;
#pragma unroll
                    for (int i = 0; i < 4; ++i) { const int yv = *(const int*)(yp + i * 256);
                        const f32x2 ylo = __builtin_amdgcn_cvt_pk_f32_fp8(yv, false), yhi = __builtin_amdgcn_cvt_pk_f32_fp8(yv, true);
                        xv[i][0] += g2[i][0] * w * ylo[0]; xv[i][1] += g2[i][1] * w * ylo[1];
                        xv[i][2] += g2[i][2] * w * yhi[0]; xv[i][3] += g2[i][3] * w * yhi[1]; }
                }
            }
        }
        if (layer >= 1 && layer < 4) {
#pragma unroll
            for (int i = 0; i < 4; ++i) *(u32x2*)(F.XB() + (size_t)row * D + i * 256 + lane * 4) = bf4_pack(xv[i]);
        }
        float ss = 0.f;
#pragma unroll
        for (int i = 0; i < 4; ++i) ss += xv[i][0] * xv[i][0] + xv[i][1] * xv[i][1] + xv[i][2] * xv[i][2] + xv[i][3] * xv[i][3];
        ss = wave_sum(ss); const float rstd = rsqrtf(ss * (1.0f / 1024.0f) + EPS);
        if (layer == 4) {
#pragma unroll
            for (int i = 0; i < 4; ++i) *(f32x4*)(F.out + (size_t)row * D + i * 256 + lane * 4) = xv[i] * rstd * Am[i];
        } else {
#pragma unroll
            for (int i = 0; i < 4; ++i) { const int c = i * 256 + lane * 4;
                const f32x4 h = xv[i] * rstd * Am[i] + Bm[i];
                u32x2 o; o.x = cvt_pk_bf16(h[0], h[1]); o.y = cvt_pk_bf16(h[2], h[3]);
                *(u32x2*)(F.H() + (size_t)row * D + c) = o; }
        }
    }
#undef R_LOAD
}

__device__ __forceinline__ void p_rows_R(const Ctx& F, const int layer) {
    if (layer == 0) { p_rows_R_one(F, 0); return; }
    const int nrows = (layer == 4) ? NLAT : NTOK;
    const int rpb = (nrows + F.G - 1) / F.G;
    const int r_hi = ((F.blk + 1) * rpb < nrows) ? (F.blk + 1) * rpb : nrows, r_lo = F.blk * rpb + F.wave;
#define R_LOAD(PXB, PSEL, PAFF, rw) { const bf16_t* src = F.XB() + (size_t)(rw) * D; _Pragma("unroll") for (int i = 0; i < 4; ++i) PXB[i] = *(const u32x2*)(src + i * 256 + lane * 4); \
        if (lane < 16) { PSEL = F.SEL()[(size_t)(rw) * 16 + lane]; PAFF = F.AFF()[(size_t)(rw) * 16 + lane]; } }
    u32x2 xbA[4], xbB[4]; int selA = -1, selB = -1; float affA = 0.f, affB = 0.f;
#pragma unroll
    for (int i = 0; i < 4; ++i) { xbA[i] = (u32x2){0u, 0u}; xbB[i] = xbA[i]; }
    { const int lane = F.lane;
      if (r_lo < r_hi) R_LOAD(xbA, selA, affA, r_lo)
      if (r_lo + 8 < r_hi) R_LOAD(xbB, selB, affB, r_lo + 8) }
    int s_cur = -1; f32x4 Am[4], Bm[4], g2[4];
#pragma unroll
    for (int i = 0; i < 4; ++i) { Am[i] = (f32x4){0.f, 0.f, 0.f, 0.f}; Bm[i] = Am[i]; g2[i] = Am[i]; }
#pragma unroll 1
    for (int row = r_lo; row < r_hi; row += 16) {
        int lane; asm volatile("v_mbcnt_lo_u32_b32 %0, -1, 0\n\tv_mbcnt_hi_u32_b32 %0, -1, %0" : "=v"(lane));
        const bool hasB = row + 8 < r_hi;
        const bool lat = row < NLAT; const int s = lat ? (row >> 11) : 16;
        f32x4 xvA[4], xvB[4];
#pragma unroll
        for (int i = 0; i < 4; ++i) { xvA[i] = bf4_unpack(xbA[i]); xvB[i] = bf4_unpack(xbB[i]); }
        const int selvA = selA, selvB = selB; const float affvA = affA, affvB = affB;
        if (s != s_cur) { s_cur = s;
#pragma unroll
            for (int i = 0; i < 4; ++i) { const int c = i * 256 + lane * 4;
                if (layer == 4) { Am[i] = *(const f32x4*)(F.in[8] + c); }
                else { const float* mp = F.mod() + ((size_t)layer * 17 + s) * NMOD; const f32x4 g = *(const f32x4*)(F.in[6] + layer * D + c);
                    Bm[i] = *(const f32x4*)(mp + c); Am[i] = g * (*(const f32x4*)(mp + D + c) + 1.0f); }
                g2[i] = *(const f32x4*)(F.mod() + ((size_t)(layer - 1) * 17 + s) * NMOD + 5 * D + c); }
#pragma unroll
            for (int i = 0; i < 4; ++i) asm volatile("" : "+v"(Am[i]), "+v"(Bm[i]), "+v"(g2[i]));
        }
        if (row + 16 < r_hi) R_LOAD(xbA, selA, affA, row + 16)
        if (row + 24 < r_hi) R_LOAD(xbB, selB, affB, row + 24)
        {
            const int pbase = lat ? ((row >> 11) * 256) : (4096 + ((row - NLAT) >> 8) * 32);
            unsigned mA = (unsigned)__ballot(lane < 16 && selvA >= 0) & 0xFFFFu, mB = hasB ? ((unsigned)__ballot(lane < 16 && selvB >= 0) & 0xFFFFu) : 0u;
            int yA[4][4], yB[4][4]; float wA[4], wB[4];
#define R_ISSUE(PY, PW, PM, SELV, AFFV) _Pragma("unroll") for (int k = 0; k < 4; ++k) { \
                if (PM) { const int e = __builtin_ctz(PM); PM &= PM - 1u; const int slot = __builtin_amdgcn_readlane(SELV, e); \
                    PW[k] = __uint_as_float(__builtin_amdgcn_readlane(__float_as_uint(AFFV), e)) * Y8_INV; \
                    const unsigned char* yp = (const unsigned char*)F.Y() + ((size_t)e * EROWS + pbase + slot) * D + lane * 4; \
                    _Pragma("unroll") for (int i = 0; i < 4; ++i) PY[k][i] = *(const int*)(yp + i * 256); } \
                else { PW[k] = 0.f; _Pragma("unroll") for (int i = 0; i < 4; ++i) PY[k][i] = 0; } }
#define R_ACC(XV, YV, WV) _Pragma("unroll") for (int i = 0; i < 4; ++i) { const f32x2 ylo = __builtin_amdgcn_cvt_pk_f32_fp8(YV[i], false), yhi = __builtin_amdgcn_cvt_pk_f32_fp8(YV[i], true); \
                XV[i][0] += g2[i][0] * WV * ylo[0]; XV[i][1] += g2[i][1] * WV * ylo[1]; XV[i][2] += g2[i][2] * WV * yhi[0]; XV[i][3] += g2[i][3] * WV * yhi[1]; }
            R_ISSUE(yA, wA, mA, selvA, affvA)
            R_ISSUE(yB, wB, mB, selvB, affvB)
#pragma unroll
            for (int k = 0; k < 4; ++k) { R_ACC(xvA, yA[k], wA[k]) R_ACC(xvB, yB[k], wB[k]) }
            while (mA) { int yt[4]; const int e = __builtin_ctz(mA); mA &= mA - 1u; const int slot = __builtin_amdgcn_readlane(selvA, e);
                const float wt = __uint_as_float(__builtin_amdgcn_readlane(__float_as_uint(affvA), e)) * Y8_INV;
                const unsigned char* yp = (const unsigned char*)F.Y() + ((size_t)e * EROWS + pbase + slot) * D + lane * 4;
#pragma unroll
                for (int i = 0; i < 4; ++i) yt[i] = *(const int*)(yp + i * 256);
                R_ACC(xvA, yt, wt) }
            while (mB) { int yt[4]; const int e = __builtin_ctz(mB); mB &= mB - 1u; const int slot = __builtin_amdgcn_readlane(selvB, e);
                const float wt = __uint_as_float(__builtin_amdgcn_readlane(__float_as_uint(affvB), e)) * Y8_INV;
                const unsigned char* yp = (const unsigned char*)F.Y() + ((size_t)e * EROWS + pbase + slot) * D + lane * 4;
#pragma unroll
                for (int i = 0; i < 4; ++i) yt[i] = *(const int*)(yp + i * 256);
                R_ACC(xvB, yt, wt) }
#undef R_ISSUE
#undef R_ACC
        }
#define R_FINISH(XV, rw) { \
        if (layer < 4) { _Pragma("unroll") for (int i = 0; i < 4; ++i) *(u32x2*)(F.XB() + (size_t)(rw) * D + i * 256 + lane * 4) = bf4_pack(XV[i]); } \
        float ss = 0.f; \
        _Pragma("unroll") for (int i = 0; i < 4; ++i) ss += XV[i][0] * XV[i][0] + XV[i][1] * XV[i][1] + XV[i][2] * XV[i][2] + XV[i][3] * XV[i][3]; \
        ss = wave_sum(ss); const float rstd = rsqrtf(ss * (1.0f / 1024.0f) + EPS); \
        if (layer == 4) { _Pragma("unroll") for (int i = 0; i < 4; ++i) *(f32x4*)(F.out + (size_t)(rw) * D + i * 256 + lane * 4) = XV[i] * rstd * Am[i]; } \
        else { _Pragma("unroll") for (int i = 0; i < 4; ++i) { const int c = i * 256 + lane * 4; const f32x4 h = XV[i] * rstd * Am[i] + Bm[i]; \
                *(u32x2*)(F.H() + (size_t)(rw) * D + c) = bf4_pack(h); } } }
        R_FINISH(xvA, row)
        if (hasB) R_FINISH(xvB, row + 8)
#undef R_FINISH
    }
#undef R_LOAD
}

__device__ __forceinline__ void p_rows_M1(const Ctx& F, const int layer) {
    const int nrows = (layer < 3) ? NTOK : NLAT;
    LAS char* WT = (LAS char*)(F.lds + LDS_SCR);
    LAS float* MV = (LAS float*)(WT + 2 * 16 * 2064);
    const int rpw = (nrows + F.G * 8 - 1) / (F.G * 8), rpb = rpw * 8, RP = (rpw + 1) >> 1;
    const int blk_lo = F.blk * rpb; const int blk_hi = (blk_lo + rpb < nrows ? blk_lo + rpb : nrows) - 1;
#define M1_S(r) (((r) < NLAT) ? ((r) >> 11) : 16)
    const int s0 = M1_S(blk_lo < nrows ? blk_lo : nrows - 1), s1 = M1_S(blk_hi > 0 ? blk_hi : 0);
#pragma unroll 1
    for (int idx = F.tid; idx < 1024 * 4; idx += 512) { const int k = idx >> 2, e4 = idx & 3;
        const f32x4 v = *(const f32x4*)(F.in[26] + ((size_t)layer * 1024 + k) * 16 + e4 * 4);
#pragma unroll
        for (int j = 0; j < 4; ++j) { const unsigned hi = cvt_pk_bf16(v[j], v[j]) & 0xffffu; const float lo = v[j] - __uint_as_float(hi << 16);
            *(LAS unsigned short*)(WT + (e4 * 4 + j) * 2064 + k * 2) = (unsigned short)hi; *(LAS unsigned short*)(WT + (16 + e4 * 4 + j) * 2064 + k * 2) = (unsigned short)cvt_pk_bf16(lo, lo); } }
#pragma unroll 1
    for (int idx = F.tid; idx < 2048; idx += 512) { const int sel = idx >> 10, c = idx & 1023, sb = sel ? s1 : s0;
        const float* mp = F.mod() + ((size_t)layer * 17 + sb) * NMOD + 3 * D; const float g = F.in[7][layer * D + c];
        MV[sel * 2048 + c] = g * (mp[D + c] + 1.0f); MV[sel * 2048 + 1024 + c] = mp[c]; }
    __syncthreads();
    const int lane = F.lane, l16 = lane & 15, pq = lane >> 4;
    const float bias = F.in[27][layer * 16 + l16];
#pragma unroll 1
    for (int p = 0; p < 2; ++p) {
        const int rbase = blk_lo + F.wave * rpw + p * RP, rcnt = (p == 0) ? RP : rpw - RP;
        int lr = l16 < rcnt ? l16 : rcnt - 1; if (lr < 0) lr = 0; int row = rbase + lr; if (row >= nrows) row = nrows - 1;
        const bool valid = l16 < rcnt && rbase + l16 < nrows;
        const int sel = (M1_S(row) != s0) ? 1 : 0;
        const bf16_t* xp = F.XB() + (size_t)row * D + pq * 8;
        u32x4 xr[32];
#pragma unroll
        for (int kk = 0; kk < 32; ++kk) xr[kk] = *(const u32x4*)(xp + kk * 32);
        float ss = 0.f;
#pragma unroll
        for (int kk = 0; kk < 32; ++kk) { const u32x4 t = xr[kk];
            const float a0 = bf_lo(t.x), a1 = bf_hi(t.x), a2 = bf_lo(t.y), a3 = bf_hi(t.y), a4 = bf_lo(t.z), a5 = bf_hi(t.z), a6 = bf_lo(t.w), a7 = bf_hi(t.w);
            ss += a0 * a0 + a1 * a1 + a2 * a2 + a3 * a3 + a4 * a4 + a5 * a5 + a6 * a6 + a7 * a7; }
        ss += __shfl_xor(ss, 16); ss += __shfl_xor(ss, 32);
        const float rstd = rsqrtf(ss * (1.0f / 1024.0f) + EPS);
#pragma unroll
        for (int kk = 0; kk < 32; ++kk) asm volatile("" : "+v"(xr[kk]));
        f32x4 acc = {0.f, 0.f, 0.f, 0.f};
        const LAS float* mv = MV + sel * 2048 + pq * 8; const LAS char* wt = WT + l16 * 2064 + pq * 16;
        unsigned char* hq = F.H2Q() + (size_t)row * D + pq * 8;
#pragma unroll
        for (int kk = 0; kk < 32; ++kk) { const u32x4 t = xr[kk];
            const f32x4 am0 = *(const LAS f32x4*)(mv + kk * 32), am1 = *(const LAS f32x4*)(mv + kk * 32 + 4), bm0 = *(const LAS f32x4*)(mv + 1024 + kk * 32), bm1 = *(const LAS f32x4*)(mv + 1024 + kk * 32 + 4);
            f32x4 h0, h1;
            h0[0] = bf_lo(t.x) * rstd * am0[0] + bm0[0]; h0[1] = bf_hi(t.x) * rstd * am0[1] + bm0[1]; h0[2] = bf_lo(t.y) * rstd * am0[2] + bm0[2]; h0[3] = bf_hi(t.y) * rstd * am0[3] + bm0[3];
            h1[0] = bf_lo(t.z) * rstd * am1[0] + bm1[0]; h1[1] = bf_hi(t.z) * rstd * am1[1] + bm1[1]; h1[2] = bf_lo(t.w) * rstd * am1[2] + bm1[2]; h1[3] = bf_hi(t.w) * rstd * am1[3] + bm1[3];
            if (valid) { u32x2 q; q.x = pk4_fp8(h0[0] * H8_SCALE, h0[1] * H8_SCALE, h0[2] * H8_SCALE, h0[3] * H8_SCALE); q.y = pk4_fp8(h1[0] * H8_SCALE, h1[1] * H8_SCALE, h1[2] * H8_SCALE, h1[3] * H8_SCALE);
                *(u32x2*)(hq + kk * 32) = q; }
            u32x4 ah, al;
            ah.x = cvt_pk_bf16(h0[0], h0[1]); ah.y = cvt_pk_bf16(h0[2], h0[3]); ah.z = cvt_pk_bf16(h1[0], h1[1]); ah.w = cvt_pk_bf16(h1[2], h1[3]);
            al.x = cvt_pk_bf16(h0[0] - bf_lo(ah.x), h0[1] - bf_hi(ah.x)); al.y = cvt_pk_bf16(h0[2] - bf_lo(ah.y), h0[3] - bf_hi(ah.y));
            al.z = cvt_pk_bf16(h1[0] - bf_lo(ah.z), h1[1] - bf_hi(ah.z)); al.w = cvt_pk_bf16(h1[2] - bf_lo(ah.w), h1[3] - bf_hi(ah.w));
            const bf16x8 bh = *(const LAS bf16x8*)(wt + kk * 64), bl = *(const LAS bf16x8*)(wt + 16 * 2064 + kk * 64);
            const bf16x8 Ah = __builtin_bit_cast(bf16x8, ah), Al = __builtin_bit_cast(bf16x8, al);
            acc = __builtin_amdgcn_mfma_f32_16x16x32_bf16(Ah, bh, acc, 0, 0, 0);
            acc = __builtin_amdgcn_mfma_f32_16x16x32_bf16(Al, bh, acc, 0, 0, 0);
            acc = __builtin_amdgcn_mfma_f32_16x16x32_bf16(Ah, bl, acc, 0, 0, 0);
            if ((kk & 1) == 1) { asm volatile("" ::: "memory"); __builtin_amdgcn_sched_barrier(0); }
        }
#pragma unroll
        for (int i = 0; i < 4; ++i) {
            const float lgt = acc[i] + bias; float mx = lgt;
#pragma unroll
            for (int o = 1; o <= 8; o <<= 1) mx = fmaxf(mx, __shfl_xor(mx, o));
            const float ex = expf(lgt - mx); float sum = ex;
#pragma unroll
            for (int o = 1; o <= 8; o <<= 1) sum += __shfl_xor(sum, o);
            const int tr = pq * 4 + i;
            if (tr < rcnt && rbase + tr < nrows) F.AFF()[(size_t)(rbase + tr) * 16 + l16] = ex / sum;
        }
    }
#undef M1_S
}

__device__ __forceinline__ void p_topk(const Ctx& F, const int layer) {
    LAS unsigned* hist = (LAS unsigned*)(F.lds + LDS_SCR);
    LAS unsigned* ctl = hist + 512;
    LAS unsigned* wsum = hist + 520;
    const int lane = F.lane, wave = F.wave;
    const bool has_c = layer < 3;
    for (int q = F.blk; q < 256; q += F.G) {
        const int b = q >> 4, e = q & 15;
        const int base = b * 2048, basec = NLAT + b * 256;
        const bool vc = has_c && F.tid < 256;
        unsigned key[4];
#pragma unroll
        for (int j = 0; j < 4; ++j) key[j] = __float_as_uint(F.AFF()[(size_t)(base + 4 * F.tid + j) * 16 + e]);
        const unsigned keyc = vc ? __float_as_uint(F.AFF()[(size_t)(basec + F.tid) * 16 + e]) : 0u;
        unsigned prefix = 0u, rem = 256u, prefc = 0u, remc = 32u;
#pragma unroll
        for (int pass = 0; pass < 4; ++pass) {
            const int shift = 24 - 8 * pass;
            hist[F.tid] = 0u;
            __syncthreads();
#pragma unroll
            for (int j = 0; j < 4; ++j) if (pass == 0 || (key[j] >> (shift + 8)) == prefix) (void)__hip_atomic_fetch_add(&hist[(key[j] >> shift) & 255u], 1u, __ATOMIC_RELAXED, __HIP_MEMORY_SCOPE_WORKGROUP);
            if (vc && (pass == 0 || (keyc >> (shift + 8)) == prefc)) (void)__hip_atomic_fetch_add(&hist[256u + ((keyc >> shift) & 255u)], 1u, __ATOMIC_RELAXED, __HIP_MEMORY_SCOPE_WORKGROUP);
            __syncthreads();
            if (wave == 0 || (wave == 1 && has_c)) {
                const LAS unsigned* hh = hist + 256 * wave; const unsigned pf = wave ? prefc : prefix, rm = wave ? remc : rem;
                const unsigned c0 = hh[4 * lane], c1 = hh[4 * lane + 1], c2 = hh[4 * lane + 2], c3 = hh[4 * lane + 3];
                const unsigned sl = c0 + c1 + c2 + c3; unsigned v = sl;
#pragma unroll
                for (int o = 1; o < 64; o <<= 1) { const unsigned t = __shfl_down(v, o); if (lane + o < 64) v += t; }
                const unsigned ab3 = v - sl, ab2 = ab3 + c3, ab1 = ab2 + c2, ab0 = ab1 + c1;
                if (ab3 < rm && rm <= ab3 + c3) { ctl[2 * wave] = (pf << 8) | (unsigned)(4 * lane + 3); ctl[2 * wave + 1] = rm - ab3; }
                if (ab2 < rm && rm <= ab2 + c2) { ctl[2 * wave] = (pf << 8) | (unsigned)(4 * lane + 2); ctl[2 * wave + 1] = rm - ab2; }
                if (ab1 < rm && rm <= ab1 + c1) { ctl[2 * wave] = (pf << 8) | (unsigned)(4 * lane + 1); ctl[2 * wave + 1] = rm - ab1; }
                if (ab0 < rm && rm <= ab0 + c0) { ctl[2 * wave] = (pf << 8) | (unsigned)(4 * lane + 0); ctl[2 * wave + 1] = rm - ab0; }
            }
            __syncthreads();
            prefix = ctl[0]; rem = ctl[1]; prefc = ctl[2]; remc = ctl[3];
        }
        unsigned eqc = 0u;
#pragma unroll
        for (int j = 0; j < 4; ++j) eqc += (key[j] == prefix) ? 1u : 0u;
        const unsigned eqcc = (vc && keyc == prefc) ? 1u : 0u;
        unsigned v = eqc, vv = eqcc;
#pragma unroll
        for (int o = 1; o < 64; o <<= 1) { const unsigned t = __shfl_up(v, o), tt = __shfl_up(vv, o); if (lane >= o) { v += t; vv += tt; } }
        if (lane == 63) { wsum[wave] = v; wsum[8 + wave] = vv; }
        __syncthreads();
        unsigned eqb = v - eqc, eqbc = vv - eqcc;
#pragma unroll
        for (int w = 0; w < 8; ++w) { eqb += (w < wave) ? wsum[w] : 0u; eqbc += (w < wave) ? wsum[8 + w] : 0u; }
        bool sel[4]; unsigned selc = 0u;
#pragma unroll
        for (int j = 0; j < 4; ++j) { const bool eq = key[j] == prefix; sel[j] = key[j] > prefix || (eq && eqb < rem); eqb += eq ? 1u : 0u; selc += sel[j] ? 1u : 0u; }
        const bool selx = vc && (keyc > prefc || (keyc == prefc && eqbc < remc)); const unsigned selcc = selx ? 1u : 0u;
        __syncthreads();
        v = selc; vv = selcc;
#pragma unroll
        for (int o = 1; o < 64; o <<= 1) { const unsigned t = __shfl_up(v, o), tt = __shfl_up(vv, o); if (lane >= o) { v += t; vv += tt; } }
        if (lane == 63) { wsum[wave] = v; wsum[8 + wave] = vv; }
        __syncthreads();
        unsigned slot = v - selc, slotc = vv - selcc;
#pragma unroll
        for (int w = 0; w < 8; ++w) { slot += (w < wave) ? wsum[w] : 0u; slotc += (w < wave) ? wsum[8 + w] : 0u; }
#pragma unroll
        for (int j = 0; j < 4; ++j) { const int row = base + 4 * F.tid + j;
            if (sel[j]) { F.MIDX()[e * EROWS + b * 256 + (int)slot] = row; F.SEL()[(size_t)row * 16 + e] = (int)slot; ++slot; }
            else F.SEL()[(size_t)row * 16 + e] = -1; }
        if (vc) { const int row = basec + F.tid;
            if (selx) { F.MIDX()[e * EROWS + 4096 + b * 32 + (int)slotc] = row; F.SEL()[(size_t)row * 16 + e] = (int)slotc; }
            else F.SEL()[(size_t)row * 16 + e] = -1; }
        __syncthreads();
    }
}

namespace pg8 {
constexpr int BM = 256, BK = 64, HALF = 128, HTB = HALF * BK * 2, STAGE_BYTES = 8 * HTB;
__device__ __forceinline__ int lds_byte(int r, int c) { const int st = (r >> 4) * 2 + (c >> 5), rr = r & 15, cc = c & 31, ob = rr * 64 + cc * 2; return st * 1024 + (ob ^ (((ob >> 9) & 1) << 5)); }
__device__ __forceinline__ void stage_rc(int b, int& R, int& C) { const int st = b / 1024, sb = b % 1024, swz = sb ^ (((sb >> 9) & 1) << 5); R = (st >> 1) * 16 + swz / 64; C = (st & 1) * 32 + (swz % 64) / 2; }
__device__ __forceinline__ int perm32(int rho) { const int n = rho >> 4, i = rho & 15; return 8 * (i >> 2) + 4 * n + (i & 3); }
struct Unit { int pm, pn, e; };

template <class P>
__device__ __forceinline__ void gemm_phase(LAS unsigned char* lds, const P& pr, const int tid) {
    constexpr int K = P::K; constexpr int nt = K / BK;
    const int wid = __builtin_amdgcn_readfirstlane(tid >> 6), wr = wid >> 2, wc = wid & 3, lane = tid & 63, fr = lane & 15, fq = lane >> 4;
    unsigned voffB[2];
#pragma unroll
    for (int i = 0; i < 2; ++i) { int R, C; stage_rc(tid * 16 + i * 8192, R, C); const int Rb = P::PERM ? ((R & ~31) + perm32(R & 31)) : R; voffB[i] = (unsigned)(Rb * K + C) * 2u; }
    const size_t kstep = (size_t)(BK * 2);
    const size_t hstep = (size_t)HALF * K * 2;
    const unsigned ldsw = (unsigned)wid * 1024u;
    const int aoff = lds_byte(wr * 64 + fr, fq * 8), boff = lds_byte(wc * 32 + fr, fq * 8);
#define PG8_SA(b, h) (((b) * 2 + (h)) * HTB)
#define PG8_SB(b, h) ((4 + (b) * 2 + (h)) * HTB)
#define PG8_STAGE(bufoff, gbase, voff) do { _Pragma("unroll") for (int _i = 0; _i < 2; ++_i) \
        __builtin_amdgcn_global_load_lds((const unsigned*)((const char*)(gbase) + (voff)[_i]), (LAS unsigned*)(lds + (bufoff) + ldsw + _i * 8192), 16, 0, 0); } while (0)
#define PG8_LDA(dst, b, h) do { _Pragma("unroll") for (int m = 0; m < 4; ++m) _Pragma("unroll") for (int k = 0; k < 2; ++k) dst[m][k] = *(const LAS bf16x8*)(lds + PG8_SA(b, h) + aoff + m * 2048 + k * 1024); } while (0)
#define PG8_LDB(dst, b, h) do { _Pragma("unroll") for (int n = 0; n < 2; ++n) _Pragma("unroll") for (int k = 0; k < 2; ++k) dst[n][k] = *(const LAS bf16x8*)(lds + PG8_SB(b, h) + boff + n * 2048 + k * 1024); } while (0)
#define PG8_MMA(ai, bj, At, Bt) do { __builtin_amdgcn_s_setprio(1); _Pragma("unroll") for (int m = 0; m < 4; ++m) _Pragma("unroll") for (int n = 0; n < 2; ++n) _Pragma("unroll") for (int k = 0; k < 2; ++k) \
        acc[ai][bj][m][n] = __builtin_amdgcn_mfma_f32_16x16x32_bf16(Bt[n][k], At[m][k], acc[ai][bj][m][n], 0, 0, 0); __builtin_amdgcn_s_setprio(0); } while (0)
#define PG8_WAIT_V(n) asm volatile("s_waitcnt vmcnt(" #n ")" ::: "memory")
#define PG8_WAIT_L(n) asm volatile("s_waitcnt lgkmcnt(" #n ")" ::: "memory")
#define PG8_BAR __builtin_amdgcn_s_barrier()
#define PG8_SCHED __builtin_amdgcn_sched_barrier(0)
    Unit cur, nxt; int ui = 0;
    if (!pr.next(0, cur)) return;
    f32x4 acc[2][2][4][2];
#pragma unroll
    for (int a = 0; a < 2; ++a)
#pragma unroll
        for (int b = 0; b < 2; ++b)
#pragma unroll
            for (int m = 0; m < 4; ++m)
#pragma unroll
                for (int n = 0; n < 2; ++n) acc[a][b][m][n] = (f32x4){0.f, 0.f, 0.f, 0.f};
    bf16x8 At[4][2], B0[2][2], B1[2][2];
    unsigned vA0[2], vA1[2];
#pragma unroll
    for (int i = 0; i < 2; ++i) { int R, C; stage_rc(tid * 16 + i * 8192, R, C); vA0[i] = (unsigned)(pr.a_row(cur, R) * K + C) * 2u; vA1[i] = (unsigned)(pr.a_row(cur, HALF + R) * K + C) * 2u; }
    const char* Ab = (const char*)pr.A;
    const char* cB = (const char*)pr.b_tile(cur);
    PG8_STAGE(PG8_SB(0, 0), cB, voffB); PG8_STAGE(PG8_SB(0, 1), cB + hstep, voffB); PG8_STAGE(PG8_SA(0, 0), Ab, vA0); PG8_STAGE(PG8_SA(0, 1), Ab, vA1);
    if (wr == 1) PG8_BAR;
    PG8_WAIT_V(2); PG8_BAR;
    PG8_STAGE(PG8_SB(1, 0), cB + kstep, voffB); PG8_STAGE(PG8_SA(1, 0), Ab + kstep, vA0); PG8_STAGE(PG8_SB(1, 1), cB + hstep + kstep, voffB);
    PG8_WAIT_V(6); PG8_BAR;
    for (;;) {
        const bool has_next = pr.next(ui + 1, nxt);
        const char* nB = has_next ? (const char*)pr.b_tile(nxt) : cB;
#pragma unroll 1
        for (int t = 0; t < nt; t += 2) {
            const bool last = (t == nt - 2);
            const char* a1 = Ab + (size_t)(t + 1) * kstep;
            const char* a2 = last ? Ab : Ab + (size_t)(t + 2) * kstep; const char* b2 = last ? nB : cB + (size_t)(t + 2) * kstep;
            const char* a3 = a2 + kstep; const char* b3 = b2 + kstep;
            PG8_LDB(B0, 0, 0); PG8_LDB(B1, 0, 1); PG8_SCHED; PG8_LDA(At, 0, 0); PG8_STAGE(PG8_SA(1, 1), a1, vA1);
            if (last && has_next) {
#pragma unroll
                for (int i = 0; i < 2; ++i) { int R, C; stage_rc(tid * 16 + i * 8192, R, C);
                    vA0[i] = (unsigned)(pr.a_row(nxt, R) * K + C) * 2u; vA1[i] = (unsigned)(pr.a_row(nxt, HALF + R) * K + C) * 2u; }
            }
            PG8_WAIT_V(8); PG8_WAIT_L(0); PG8_BAR; PG8_MMA(0, 0, At, B0); PG8_MMA(0, 1, At, B1); PG8_BAR; PG8_SCHED;
            PG8_LDA(At, 0, 1); PG8_STAGE(PG8_SB(0, 0), b2, voffB); PG8_STAGE(PG8_SB(0, 1), b2 + hstep, voffB); PG8_STAGE(PG8_SA(0, 0), a2, vA0);
            PG8_WAIT_V(8); PG8_WAIT_L(0); PG8_BAR; PG8_MMA(1, 0, At, B0); PG8_MMA(1, 1, At, B1); PG8_BAR; PG8_SCHED;
            PG8_LDB(B0, 1, 0); PG8_LDB(B1, 1, 1); PG8_SCHED; PG8_LDA(At, 1, 0); PG8_STAGE(PG8_SA(0, 1), a2, vA1);
            PG8_WAIT_V(8); PG8_WAIT_L(0); PG8_BAR; PG8_MMA(0, 0, At, B0); PG8_MMA(0, 1, At, B1); PG8_BAR; PG8_SCHED;
            PG8_LDA(At, 1, 1); PG8_STAGE(PG8_SB(1, 0), b3, voffB); PG8_STAGE(PG8_SB(1, 1), b3 + hstep, voffB); PG8_STAGE(PG8_SA(1, 0), a3, vA0);
            PG8_WAIT_V(8); PG8_WAIT_L(0); PG8_BAR; PG8_MMA(1, 0, At, B0); PG8_MMA(1, 1, At, B1); PG8_BAR; PG8_SCHED;
        }
        if (wr == 0) PG8_BAR;
        { int ln; asm volatile("v_mbcnt_lo_u32_b32 %0, -1, 0\n\tv_mbcnt_hi_u32_b32 %0, -1, %0" : "=v"(ln));
          pr.epi(acc, cur, wr, wc, ln & 15, ln >> 4); }
        if (!has_next) break;
#pragma unroll
        for (int a = 0; a < 2; ++a)
#pragma unroll
            for (int b = 0; b < 2; ++b)
#pragma unroll
                for (int m = 0; m < 4; ++m)
#pragma unroll
                    for (int n = 0; n < 2; ++n) acc[a][b][m][n] = (f32x4){0.f, 0.f, 0.f, 0.f};
        cur = nxt; cB = nB; ++ui;
        if (wr == 1) PG8_BAR;
    }
    PG8_WAIT_V(0);
    PG8_BAR;
#undef PG8_SA
#undef PG8_SB
#undef PG8_STAGE
#undef PG8_LDA
#undef PG8_LDB
#undef PG8_MMA
#undef PG8_WAIT_V
#undef PG8_WAIT_L
#undef PG8_BAR
#undef PG8_SCHED
}
template <class P>
__device__ __forceinline__ void gemm_phase8(LAS unsigned char* lds, const P& pr, const int tid) {
    constexpr int K = P::K;
    constexpr int nt = K / 128;
    const int wid = __builtin_amdgcn_readfirstlane(tid >> 6), wr = wid >> 2, wc = wid & 3, lane = tid & 63, fr = lane & 15, fq = lane >> 4;
    unsigned voffB[2];
#pragma unroll
    for (int i = 0; i < 2; ++i) { int R, C; stage_rc(tid * 16 + i * 8192, R, C); const int Rb = P::PERM ? ((R & ~31) + perm32(R & 31)) : R; voffB[i] = (unsigned)(Rb * K + 2 * C); }
    const size_t kstep = (size_t)(BK * 2);
    const size_t hstep = (size_t)HALF * K;
    const unsigned ldsw = (unsigned)wid * 1024u;
    const int aoff = lds_byte(wr * 64 + fr, (fq & 1) * 16) + (fq >> 1) * 1024, boff = lds_byte(wc * 32 + fr, (fq & 1) * 16) + (fq >> 1) * 1024;
#define PG8_SA(b, h) (((b) * 2 + (h)) * HTB)
#define PG8_SB(b, h) ((4 + (b) * 2 + (h)) * HTB)
#define PG8_STAGE(bufoff, gbase, voff) do { _Pragma("unroll") for (int _i = 0; _i < 2; ++_i) \
        __builtin_amdgcn_global_load_lds((const unsigned*)((const char*)(gbase) + (voff)[_i]), (LAS unsigned*)(lds + (bufoff) + ldsw + _i * 8192), 16, 0, 0); } while (0)
#define PG8_LD32(dst, base) do { typedef int i32x4_ __attribute__((ext_vector_type(4))); const i32x4_ _lo = *(const LAS i32x4_*)(lds + (base)), _hi = *(const LAS i32x4_*)(lds + (base) + 16); \
        dst = __builtin_shufflevector(_lo, _hi, 0, 1, 2, 3, 4, 5, 6, 7); } while (0)
#define PG8_LDA(dst, b, h) do { _Pragma("unroll") for (int m = 0; m < 4; ++m) PG8_LD32(dst[m], PG8_SA(b, h) + aoff + m * 2048); } while (0)
#define PG8_LDB(dst, b, h) do { _Pragma("unroll") for (int n = 0; n < 2; ++n) PG8_LD32(dst[n], PG8_SB(b, h) + boff + n * 2048); } while (0)
#define PG8_MMA(ai, bj, At, Bt) do { __builtin_amdgcn_s_setprio(1); _Pragma("unroll") for (int m = 0; m < 4; ++m) _Pragma("unroll") for (int n = 0; n < 2; ++n) \
        acc[ai][bj][m][n] = __builtin_amdgcn_mfma_scale_f32_16x16x128_f8f6f4(Bt[n], At[m], acc[ai][bj][m][n], 0, 0, 0, 0x7F7F7F7F, 0, 0x7F7F7F7F); __builtin_amdgcn_s_setprio(0); } while (0)
#define PG8_WAIT_V(n) asm volatile("s_waitcnt vmcnt(" #n ")" ::: "memory")
#define PG8_WAIT_L(n) asm volatile("s_waitcnt lgkmcnt(" #n ")" ::: "memory")
#define PG8_BAR __builtin_amdgcn_s_barrier()
#define PG8_SCHED __builtin_amdgcn_sched_barrier(0)
    Unit cur, nxt; int ui = 0;
    if (!pr.next(0, cur)) return;
    f32x4 acc[2][2][4][2];
#pragma unroll
    for (int a = 0; a < 2; ++a)
#pragma unroll
        for (int b = 0; b < 2; ++b)
#pragma unroll
            for (int m = 0; m < 4; ++m)
#pragma unroll
                for (int n = 0; n < 2; ++n) acc[a][b][m][n] = (f32x4){0.f, 0.f, 0.f, 0.f};
    i32x8 At[4], B0[2], B1[2];
    unsigned vA0[2], vA1[2];
#pragma unroll
    for (int i = 0; i < 2; ++i) { int R, C; stage_rc(tid * 16 + i * 8192, R, C); vA0[i] = (unsigned)(pr.a_row(cur, R) * K + 2 * C); vA1[i] = (unsigned)(pr.a_row(cur, HALF + R) * K + 2 * C); }
    const char* Ab = (const char*)pr.A;
    const char* cB = (const char*)pr.b_tile(cur);
    PG8_STAGE(PG8_SB(0, 0), cB, voffB); PG8_STAGE(PG8_SB(0, 1), cB + hstep, voffB); PG8_STAGE(PG8_SA(0, 0), Ab, vA0); PG8_STAGE(PG8_SA(0, 1), Ab, vA1);
    if (wr == 1) PG8_BAR;
    PG8_WAIT_V(2); PG8_BAR;
    PG8_STAGE(PG8_SB(1, 0), cB + kstep, voffB); PG8_STAGE(PG8_SA(1, 0), Ab + kstep, vA0); PG8_STAGE(PG8_SB(1, 1), cB + hstep + kstep, voffB);
    PG8_WAIT_V(6); PG8_BAR;
    for (;;) {
        const bool has_next = pr.next(ui + 1, nxt);
        const char* nB = has_next ? (const char*)pr.b_tile(nxt) : cB;
        int ridx[2][2] = {{0, 0}, {0, 0}};
        if constexpr (P::GATHER) { if (has_next) { const int* ip = pr.a_idx_ptr(nxt);
            int ln; asm volatile("v_mbcnt_lo_u32_b32 %0, -1, 0\n\tv_mbcnt_hi_u32_b32 %0, -1, %0" : "=v"(ln)); const int tid2 = wid * 64 + ln;
#pragma unroll
            for (int i = 0; i < 2; ++i) { int R, C; stage_rc(tid2 * 16 + i * 8192, R, C); ridx[0][i] = ip[R]; ridx[1][i] = ip[HALF + R]; } } }
#pragma unroll 1
        for (int t = 0; t < nt; t += 2) {
            const bool last = (t == nt - 2);
            const char* a1 = Ab + (size_t)(t + 1) * kstep;
            const char* a2 = last ? Ab : Ab + (size_t)(t + 2) * kstep; const char* b2 = last ? nB : cB + (size_t)(t + 2) * kstep;
            const char* a3 = a2 + kstep; const char* b3 = b2 + kstep;
            PG8_LDB(B0, 0, 0); PG8_LDB(B1, 0, 1); PG8_SCHED; PG8_LDA(At, 0, 0); PG8_STAGE(PG8_SA(1, 1), a1, vA1);
            if (last && has_next) {
#pragma unroll
                for (int i = 0; i < 2; ++i) { int R, C; stage_rc(tid * 16 + i * 8192, R, C);
                    if constexpr (P::GATHER) { vA0[i] = (unsigned)(ridx[0][i] * K + 2 * C); vA1[i] = (unsigned)(ridx[1][i] * K + 2 * C); }
                    else { vA0[i] = (unsigned)(pr.a_row(nxt, R) * K + 2 * C); vA1[i] = (unsigned)(pr.a_row(nxt, HALF + R) * K + 2 * C); } }
            }
            PG8_WAIT_V(8); PG8_WAIT_L(0); PG8_BAR; PG8_MMA(0, 0, At, B0); PG8_MMA(0, 1, At, B1); PG8_BAR; PG8_SCHED;
            PG8_LDA(At, 0, 1); PG8_STAGE(PG8_SB(0, 0), b2, voffB); PG8_STAGE(PG8_SB(0, 1), b2 + hstep, voffB); PG8_STAGE(PG8_SA(0, 0), a2, vA0);
            PG8_WAIT_V(8); PG8_WAIT_L(0); PG8_BAR; PG8_MMA(1, 0, At, B0); PG8_MMA(1, 1, At, B1); PG8_BAR; PG8_SCHED;
            PG8_LDB(B0, 1, 0); PG8_LDB(B1, 1, 1); PG8_SCHED; PG8_LDA(At, 1, 0); PG8_STAGE(PG8_SA(0, 1), a2, vA1);
            PG8_WAIT_V(8); PG8_WAIT_L(0); PG8_BAR; PG8_MMA(0, 0, At, B0); PG8_MMA(0, 1, At, B1); PG8_BAR; PG8_SCHED;
            PG8_LDA(At, 1, 1); PG8_STAGE(PG8_SB(1, 0), b3, voffB); PG8_STAGE(PG8_SB(1, 1), b3 + hstep, voffB); PG8_STAGE(PG8_SA(1, 0), a3, vA0);
            PG8_WAIT_V(8); PG8_WAIT_L(0); PG8_BAR; PG8_MMA(1, 0, At, B0); PG8_MMA(1, 1, At, B1); PG8_BAR; PG8_SCHED;
        }
        if (wr == 0) PG8_BAR;
        { int ln; asm volatile("v_mbcnt_lo_u32_b32 %0, -1, 0\n\tv_mbcnt_hi_u32_b32 %0, -1, %0" : "=v"(ln));
          pr.epi(acc, cur, wr, wc, ln & 15, ln >> 4); }
        if (!has_next) break;
#pragma unroll
        for (int a = 0; a < 2; ++a)
#pragma unroll
            for (int b = 0; b < 2; ++b)
#pragma unroll
                for (int m = 0; m < 4; ++m)
#pragma unroll
                    for (int n = 0; n < 2; ++n) acc[a][b][m][n] = (f32x4){0.f, 0.f, 0.f, 0.f};
        cur = nxt; cB = nB; ++ui;
        if (wr == 1) PG8_BAR;
    }
    PG8_WAIT_V(0);
    PG8_BAR;
#undef PG8_SA
#undef PG8_SB
#undef PG8_STAGE
#undef PG8_LD32
#undef PG8_LDA
#undef PG8_LDB
#undef PG8_MMA
#undef PG8_WAIT_V
#undef PG8_WAIT_L
#undef PG8_BAR
#undef PG8_SCHED
}
}

typedef f32x4 AccT[2][2][4][2];

struct DenseOrder {
    int nM, nN, nx, x, li, cpx;
    __device__ __forceinline__ void init(int nM_, int nN_, int G, int blk) { nM = nM_; nN = nN_; nx = (G % 8 == 0) ? 8 : 1; x = blk % nx; li = blk / nx; cpx = G / nx; }
    __device__ __forceinline__ bool next(int i, pg8::Unit& u) const {
        const int npx = (nM - x + nx - 1) / nx, lu = i * cpx + li; if (lu >= npx * nN) return false;
        u.pm = (lu / nN) * nx + x; u.pn = lu % nN; u.e = 0; return true; }
};
struct MoeOrder {
    int npan, nN, nx, x, li, cpx;
    __device__ __forceinline__ void init(int npan_, int nN_, int G, int blk) { npan = npan_; nN = nN_; nx = (G % 8 == 0) ? 8 : 1; x = blk % nx; li = blk / nx; cpx = G / nx; }
    __device__ __forceinline__ bool next(int i, pg8::Unit& u) const {
        const int per = npan * nN, lu = i * cpx + li; if (lu >= (NE / nx) * per) return false;
        const int el = lu / per, rem = lu % per; u.e = el * nx + x; u.pm = rem / nN; u.pn = rem % nN; return true; }
};

struct ProbQKV {
    static constexpr int K = 1024; static constexpr bool PERM = true, GATHER = false;
    const bf16_t* A; const bf16_t* Bt; bf16_t* O; const float* rope; DenseOrder ord;
    __device__ __forceinline__ bool next(int i, pg8::Unit& u) const { return ord.next(i, u); }
    __device__ __forceinline__ int a_row(const pg8::Unit& u, int r) const { return u.pm * 256 + r; }
    __device__ __forceinline__ const int* a_idx_ptr(const pg8::Unit&) const { return nullptr; }
    __device__ __forceinline__ const bf16_t* b_tile(const pg8::Unit& u) const { return Bt + (size_t)u.pn * 256 * K; }
    __device__ __forceinline__ void epi(const AccT& acc, const pg8::Unit& u, int wr, int wc, int fr, int fq) const {
        const bool dorope = (u.pn < 8) && (u.pm < 128);
#pragma unroll
        for (int ai = 0; ai < 2; ++ai)
#pragma unroll
            for (int m = 0; m < 4; ++m) {
                const int row = u.pm * 256 + ai * 128 + wr * 64 + m * 16 + fr; const int t = row & 2047;
                f32x4 c0 = {1.f, 0.f, 1.f, 0.f}, c1 = {1.f, 0.f, 1.f, 0.f};
                if (dorope) { const float* rp = rope + ((size_t)t * 32 + (((wc & 1) * 32 + 8 * fq) >> 1)) * 2; c0 = *(const f32x4*)rp; c1 = *(const f32x4*)(rp + 4); }
#pragma unroll
                for (int bj = 0; bj < 2; ++bj) {
                    const int col = u.pn * 256 + bj * 128 + wc * 32 + 8 * fq;
                    f32x4 v0 = acc[ai][bj][m][0], v1 = acc[ai][bj][m][1];
                    if (dorope) {
                        f32x4 o0, o1;
                        o0[0] = v0[0] * c0[0] - v0[1] * c0[1]; o0[1] = v0[0] * c0[1] + v0[1] * c0[0];
                        o0[2] = v0[2] * c0[2] - v0[3] * c0[3]; o0[3] = v0[2] * c0[3] + v0[3] * c0[2];
                        o1[0] = v1[0] * c1[0] - v1[1] * c1[1]; o1[1] = v1[0] * c1[1] + v1[1] * c1[0];
                        o1[2] = v1[2] * c1[2] - v1[3] * c1[3]; o1[3] = v1[2] * c1[3] + v1[3] * c1[2];
                        v0 = o0; v1 = o1;
                    }
                    u32x4 w; w.x = cvt_pk_bf16(v0[0], v0[1]); w.y = cvt_pk_bf16(v0[2], v0[3]); w.z = cvt_pk_bf16(v1[0], v1[1]); w.w = cvt_pk_bf16(v1[2], v1[3]);
                    *(u32x4*)(O + (size_t)row * 3072 + col) = w;
                }
            }
    }
};

template <bool GLU> struct ProbResid {
    static constexpr int K = 1024; static constexpr bool PERM = false, GATHER = false; static constexpr bool F8 = GLU ? (GLU_FP8 != 0) : (WO_FP8 != 0);
    const unsigned char* A; const unsigned char* Bt; bf16_t* X; const float* Xlat; const float* Xctx; bool in_f32; const float* gate; DenseOrder ord;
    __device__ __forceinline__ bool next(int i, pg8::Unit& u) const { return ord.next(i, u); }
    __device__ __forceinline__ int a_row(const pg8::Unit& u, int r) const { return u.pm * 256 + r; }
    __device__ __forceinline__ const int* a_idx_ptr(const pg8::Unit&) const { return nullptr; }
    __device__ __forceinline__ const unsigned char* b_tile(const pg8::Unit& u) const { return Bt + (size_t)u.pn * 256 * K * (F8 ? 1 : 2); }
    __device__ __forceinline__ void epi(const AccT& acc, const pg8::Unit& u, int wr, int wc, int fr, int fq) const {
        constexpr float S8 = F8 ? A8_INV * W8_INV : 1.0f;
        const int s = (u.pm < 128) ? (u.pm >> 3) : 16; const float* gp = gate + (size_t)s * NMOD;
        f32x4 gv[2][2];
#pragma unroll
        for (int bj = 0; bj < 2; ++bj)
#pragma unroll
            for (int n = 0; n < 2; ++n) gv[bj][n] = *(const f32x4*)(gp + (GLU ? u.pn * 128 : u.pn * 256 + bj * 128) + wc * 32 + 16 * n + 4 * fq) * S8;
#pragma unroll
        for (int ai = 0; ai < 2; ++ai)
#pragma unroll
            for (int m = 0; m < 4; ++m) {
                const int row = u.pm * 256 + ai * 128 + wr * 64 + m * 16 + fr;
                bf16_t* xr = X + (size_t)row * D; const float* xs = (u.pm < 128) ? Xlat + (size_t)row * D : Xctx + (size_t)(row - NLAT) * D;
#define RES_LD(col) (in_f32 ? *(const f32x4*)(xs + (col)) : bf4_unpack(*(const u32x2*)(xr + (col))))
                if constexpr (GLU) {
#pragma unroll
                    for (int n = 0; n < 2; ++n) { const int col = u.pn * 128 + wc * 32 + 16 * n + 4 * fq;
                        const f32x4 a = acc[ai][0][m][n], b = acc[ai][1][m][n], g = gv[0][n]; f32x4 xv = RES_LD(col);
                        xv[0] += g[0] * a[0] * sigmoidf_(b[0] * S8); xv[1] += g[1] * a[1] * sigmoidf_(b[1] * S8); xv[2] += g[2] * a[2] * sigmoidf_(b[2] * S8); xv[3] += g[3] * a[3] * sigmoidf_(b[3] * S8);
                        *(u32x2*)(xr + col) = bf4_pack(xv); }
                } else {
#pragma unroll
                    for (int bj = 0; bj < 2; ++bj)
#pragma unroll
                        for (int n = 0; n < 2; ++n) { const int col = u.pn * 256 + bj * 128 + wc * 32 + 16 * n + 4 * fq;
                            const f32x4 a = acc[ai][bj][m][n], g = gv[bj][n]; f32x4 xv = RES_LD(col);
                            xv += g * a; *(u32x2*)(xr + col) = bf4_pack(xv); }
                }
#undef RES_LD
            }
    }
};

struct ProbMoe1 {
    static constexpr int K = 1024; static constexpr bool PERM = true, GATHER = true;
    const unsigned char* A; const unsigned char* Bt; void* O; const int* midx; MoeOrder ord;
    __device__ __forceinline__ bool next(int i, pg8::Unit& u) const { return ord.next(i, u); }
    __device__ __forceinline__ int a_row(const pg8::Unit& u, int r) const { return midx[u.e * EROWS + u.pm * 256 + r]; }
    __device__ __forceinline__ const int* a_idx_ptr(const pg8::Unit& u) const { return midx + u.e * EROWS + u.pm * 256; }
    __device__ __forceinline__ const unsigned char* b_tile(const pg8::Unit& u) const { return Bt + ((size_t)u.e * 4096 + (size_t)u.pn * 256) * K; }
    __device__ __forceinline__ void epi(const AccT& acc, const pg8::Unit& u, int wr, int wc, int fr, int fq) const {
        constexpr float S = H8_INV * W8_INV, ZC = -S * 1.4426950408889634f, HC = S * S * HID8_SCALE;
#pragma unroll
        for (int ai = 0; ai < 2; ++ai)
#pragma unroll
            for (int m = 0; m < 4; ++m) {
                const size_t row = (size_t)u.e * EROWS + u.pm * 256 + ai * 128 + wr * 64 + m * 16 + fr; const int col = u.pn * 128 + wc * 32 + 8 * fq;
                float h[8];
                constexpr float HCI = 1.0f / HC;
#pragma unroll
                for (int n = 0; n < 2; ++n) {
                    const f32x4 g = acc[ai][0][m][n], up = acc[ai][1][m][n];
#pragma unroll
                    for (int k = 0; k < 4; k += 2) {
                        const f32x2 g2 = {g[k], g[k + 1]}, u2 = {up[k], up[k + 1]};
                        const f32x2 t2 = g2 * u2, z2 = g2 * ZC;
                        f32x2 e2; e2[0] = __builtin_amdgcn_exp2f(z2[0]); e2[1] = __builtin_amdgcn_exp2f(z2[1]);
                        const f32x2 d2 = __builtin_elementwise_fma(e2, (f32x2){HCI, HCI}, (f32x2){HCI, HCI});
                        f32x2 r2; r2[0] = __builtin_amdgcn_rcpf(d2[0]); r2[1] = __builtin_amdgcn_rcpf(d2[1]);
                        const f32x2 h2 = t2 * r2; h[n * 4 + k] = h2[0]; h[n * 4 + k + 1] = h2[1];
                    }
                }
#if MOE2_FP8
                u32x2 w; w.x = pk4_fp8(h[0], h[1], h[2], h[3]); w.y = pk4_fp8(h[4], h[5], h[6], h[7]);
                *(u32x2*)((unsigned char*)O + row * FF + col) = w;
#else
                u32x4 w; w.x = cvt_pk_bf16(h[0] * HID8_INV, h[1] * HID8_INV); w.y = cvt_pk_bf16(h[2] * HID8_INV, h[3] * HID8_INV); w.z = cvt_pk_bf16(h[4] * HID8_INV, h[5] * HID8_INV); w.w = cvt_pk_bf16(h[6] * HID8_INV, h[7] * HID8_INV);
                *(u32x4*)((bf16_t*)O + row * FF + col) = w;
#endif
            }
    }
};
struct ProbMoe2 {
    static constexpr int K = 2048; static constexpr bool PERM = true, GATHER = false;
    const void* A; const void* Bt; bf16_t* O; MoeOrder ord;
    __device__ __forceinline__ bool next(int i, pg8::Unit& u) const { return ord.next(i, u); }
    __device__ __forceinline__ int a_row(const pg8::Unit& u, int r) const { return u.e * EROWS + u.pm * 256 + r; }
    __device__ __forceinline__ const int* a_idx_ptr(const pg8::Unit&) const { return nullptr; }
#if MOE2_FP8
    __device__ __forceinline__ const unsigned char* b_tile(const pg8::Unit& u) const { return (const unsigned char*)Bt + ((size_t)u.e * 1024 + (size_t)u.pn * 256) * K; }
#else
    __device__ __forceinline__ const bf16_t* b_tile(const pg8::Unit& u) const { return (const bf16_t*)Bt + ((size_t)u.e * 1024 + (size_t)u.pn * 256) * K; }
#endif
    __device__ __forceinline__ void epi(const AccT& acc, const pg8::Unit& u, int wr, int wc, int fr, int fq) const {
        constexpr float S = MOE2_FP8 ? HID8_INV * W8_INV : 1.0f;
#pragma unroll
        for (int ai = 0; ai < 2; ++ai)
#pragma unroll
            for (int m = 0; m < 4; ++m) {
                const size_t row = (size_t)u.e * EROWS + u.pm * 256 + ai * 128 + wr * 64 + m * 16 + fr;
#pragma unroll
                for (int bj = 0; bj < 2; ++bj) { const int col = u.pn * 256 + bj * 128 + wc * 32 + 8 * fq; const f32x4 v0 = acc[ai][bj][m][0] * (S * Y8_SCALE), v1 = acc[ai][bj][m][1] * (S * Y8_SCALE);
                    u32x2 w; w.x = pk4_fp8(v0[0], v0[1], v0[2], v0[3]); w.y = pk4_fp8(v1[0], v1[1], v1[2], v1[3]);
                    *(u32x2*)((unsigned char*)O + row * D + col) = w; }
            }
    }
};

namespace att {
constexpr int KVBLK = 64; constexpr float SCALE = 0.125f, THR = 8.f;
constexpr int SHM_V = KVBLK * 128 * 2, SHM_K = KVBLK * 128 * 2;
constexpr int EXS = 132;
constexpr int EX_BYTES = 2 * 128 * EXS * 4;
constexpr int WS_OFF = EX_BYTES;
static_assert(3 * SHM_V + 3 * SHM_K <= EX_BYTES, "K/V buffers inside exchange region");
static_assert(LDS_SCR + WS_OFF + 8 * 64 * 4 <= LDS_BYTES, "attention LDS");
#define KSWZ(row, colB) ((row) * 256 + ((colB) ^ (((row) & 7) << 4)))
#define SBAR() __builtin_amdgcn_sched_barrier(0)
__device__ __forceinline__ int crow(int r, int hi) { return (r & 3) + 8 * (r >> 2) + 4 * hi; }
__device__ __forceinline__ void partialSM(f32x16& p0, f32x16& p1, float& m_reg, float& mn, float& alpha) {
    constexpr float THR2 = THR * 1.4426950408889634f;
    float pmax = p0[0];
#pragma unroll
    for (int r = 1; r < 16; ++r) pmax = fmaxf(pmax, p0[r]);
#pragma unroll
    for (int r = 0; r < 16; ++r) pmax = fmaxf(pmax, p1[r]);
    { auto rr = __builtin_amdgcn_permlane32_swap(__float_as_uint(pmax), __float_as_uint(pmax), false, false);
      pmax = fmaxf(__uint_as_float(rr[0]), __uint_as_float(rr[1])); }
    if (__builtin_expect(__all(m_reg == 0.f && pmax <= THR2), 1)) { alpha = 1.f; }
    else {
        const float newm = (pmax - m_reg > THR2) ? fmaxf(m_reg, pmax) : m_reg;
        alpha = __builtin_amdgcn_exp2f(m_reg - newm); m_reg = newm;
#pragma unroll
        for (int r = 0; r < 16; ++r) { p0[r] -= newm; p1[r] -= newm; }
    }
    mn = m_reg;
#pragma unroll
    for (int r = 0; r < 16; ++r) p0[r] = __builtin_amdgcn_exp2f(p0[r]);
}
__device__ __forceinline__ void finishSM(f32x16& p0, f32x16& p1, float alpha, float& l_reg, bf16x8& pa0, bf16x8& pa1, bf16x8& pa2, bf16x8& pa3) {
#pragma unroll
    for (int r = 0; r < 16; ++r) p1[r] = __builtin_amdgcn_exp2f(p1[r]);
    float ps = 0;
#pragma unroll
    for (int r = 0; r < 16; ++r) ps += p0[r];
#pragma unroll
    for (int r = 0; r < 16; ++r) ps += p1[r];
    { auto rr = __builtin_amdgcn_permlane32_swap(__float_as_uint(ps), __float_as_uint(ps), false, false);
      ps = __uint_as_float(rr[0]) + __uint_as_float(rr[1]); }
    l_reg = l_reg * alpha + ps;
#define PK4(P, BASE, OUT) do { unsigned a0 = cvt_pk_bf16(P[BASE + 0], P[BASE + 1]), a1 = cvt_pk_bf16(P[BASE + 2], P[BASE + 3]);   \
    unsigned b0 = cvt_pk_bf16(P[BASE + 4], P[BASE + 5]), b1 = cvt_pk_bf16(P[BASE + 6], P[BASE + 7]);                              \
    auto r0 = __builtin_amdgcn_permlane32_swap(a0, b0, false, false); auto r1 = __builtin_amdgcn_permlane32_swap(a1, b1, false, false); \
    u32x4 w = {r0[0], r1[0], r0[1], r1[1]}; OUT = *reinterpret_cast<bf16x8*>(&w); } while (0)
    PK4(p0, 0, pa0); PK4(p0, 8, pa1); PK4(p1, 0, pa2); PK4(p1, 8, pa3);
#undef PK4
}
__device__ __forceinline__ void qkt(f32x16& p0, f32x16& p1, const LAS char* Ks, const bf16x8* qr, int r32, int hi, int cofs) {
    p0 = f32x16{}; p1 = f32x16{};
#pragma unroll
    for (int d0 = 0; d0 < 4; ++d0) { const int cb = cofs + (d0 * 16 + hi * 8) * 2;
        const bf16x8 b0 = *reinterpret_cast<const LAS bf16x8*>(Ks + KSWZ(r32, cb));
        const bf16x8 b1 = *reinterpret_cast<const LAS bf16x8*>(Ks + KSWZ(32 + r32, cb));
        p0 = __builtin_amdgcn_mfma_f32_32x32x16_bf16(b0, qr[d0], p0, 0, 0, 0);
        p1 = __builtin_amdgcn_mfma_f32_32x32x16_bf16(b1, qr[d0], p1, 0, 0, 0); }
}
__device__ __forceinline__ int v_st(int k, int c) { const int kk = (k & ~0xC) | ((k & 4) << 1) | ((k & 8) >> 1); return ((kk >> 3) * 4 + (c >> 5)) * 512 + ((kk & 7) * 32 + (c & 31)) * 2; }
__device__ __forceinline__ int v_rd_base(int lane) { return ((lane & 3) << 3) | (((lane >> 2) & 3) << 6) | (((lane >> 4) & 1) << 5) | (((lane >> 5) & 1) << 8); }
constexpr int v_rd_off(int d0, int ks, int half) { return d0 * 512 + ks * 4096 + half * 2048; }
template <int OFF> __device__ __forceinline__ s16x4 tr_read(int vb) {
    s16x4 r; asm volatile("ds_read_b64_tr_b16 %0, %1 offset:%2" : "=&v"(r) : "v"(vb), "i"(OFF) : "memory"); return r;
}
template <int D0> __device__ __forceinline__ void pv_one(f32x16& od, int vb, bf16x8 pa0, bf16x8 pa1, bf16x8 pa2, bf16x8 pa3) {
    const s16x4 l0 = tr_read<v_rd_off(D0, 0, 0)>(vb), h0 = tr_read<v_rd_off(D0, 0, 1)>(vb), l1 = tr_read<v_rd_off(D0, 1, 0)>(vb), h1 = tr_read<v_rd_off(D0, 1, 1)>(vb);
    const s16x4 l2 = tr_read<v_rd_off(D0, 2, 0)>(vb), h2 = tr_read<v_rd_off(D0, 2, 1)>(vb), l3 = tr_read<v_rd_off(D0, 3, 0)>(vb), h3 = tr_read<v_rd_off(D0, 3, 1)>(vb);
    asm volatile("s_waitcnt lgkmcnt(0)" ::: "memory"); SBAR();
#define PK(L, H) (bf16x8){L[0], L[1], L[2], L[3], H[0], H[1], H[2], H[3]}
    od = __builtin_amdgcn_mfma_f32_32x32x16_bf16(pa0, PK(l0, h0), od, 0, 0, 0);
    od = __builtin_amdgcn_mfma_f32_32x32x16_bf16(pa1, PK(l1, h1), od, 0, 0, 0);
    od = __builtin_amdgcn_mfma_f32_32x32x16_bf16(pa2, PK(l2, h2), od, 0, 0, 0);
    od = __builtin_amdgcn_mfma_f32_32x32x16_bf16(pa3, PK(l3, h3), od, 0, 0, 0);
#undef PK
}
__device__ __forceinline__ void pv_d0(f32x16* o, int vb, bf16x8 pa0, bf16x8 pa1, bf16x8 pa2, bf16x8 pa3) {
    pv_one<0>(o[0], vb, pa0, pa1, pa2, pa3); pv_one<1>(o[1], vb, pa0, pa1, pa2, pa3); pv_one<2>(o[2], vb, pa0, pa1, pa2, pa3); pv_one<3>(o[3], vb, pa0, pa1, pa2, pa3);
}

__device__ __forceinline__ void unit(const bf16_t* __restrict__ QKVb, bf16_t* __restrict__ AOb, int qrow0, int h, int klat0, int ntl, int kctx0, int NT,
                                     float lam, float oscale, const float* __restrict__ subg, LAS char* lds, const int wave_s) {
    int lane_f; asm volatile("v_mbcnt_lo_u32_b32 %0, -1, 0\n\tv_mbcnt_hi_u32_b32 %0, -1, %0" : "=v"(lane_f));
    const int tid = wave_s * 64 + lane_f;
    const int wid = tid >> 6, lane = tid & 63, r32 = lane & 31, hi = lane >> 5, comp = wid >> 2, wq = wid & 3;
    LAS char* V_lds = lds; LAS char* K_lds = lds + 3 * SHM_V;
    LAS float* wsl = (LAS float*)(lds + WS_OFF) + wid * 64; LAS float* li_l = wsl; LAS float* al_l = wsl + 32;
    float m_reg = 0.f, l_reg = 0; f32x16 o[4] = {}; bf16x8 qr[4];
    const bf16_t* Qw = QKVb + (size_t)(qrow0 + wq * 32 + r32) * 3072 + h * 128 + comp * 64 + hi * 8;
#pragma unroll
    for (int d0 = 0; d0 < 4; ++d0) qr[d0] = *reinterpret_cast<const bf16x8*>(Qw + d0 * 16);
    const int cofs = comp * 128;
    const int sr = tid >> 4, sc = (tid & 15) * 8, vst0 = v_st(sr, sc), vst1 = v_st(32 + sr, sc);
    const int vb0 = (int)(uintptr_t)V_lds + v_rd_base(lane);
    const bf16_t* Kc = QKVb + 1024 + h * 128 + sc; const bf16_t* Vc = QKVb + 2048 + h * 128 + sc;
    struct { bf16x8 vs0, vs1, ks0, ks1; } sr_[2];
#define KROW(j) (((j) < ntl) ? (klat0 + (j) * 64) : (kctx0 + ((j) - ntl) * 64))
#define SLOAD(i, j) do { const size_t _r = (size_t)(KROW(j) + sr) * 3072; sr_[i].vs0 = *reinterpret_cast<const bf16x8*>(Vc + _r); sr_[i].vs1 = *reinterpret_cast<const bf16x8*>(Vc + _r + 32 * 3072); \
    sr_[i].ks0 = *reinterpret_cast<const bf16x8*>(Kc + _r); sr_[i].ks1 = *reinterpret_cast<const bf16x8*>(Kc + _r + 32 * 3072); } while (0)
#define SWRITE(b, i) do { *(LAS bf16x8*)(V_lds + (b) * SHM_V + vst0) = sr_[i].vs0;          \
    *(LAS bf16x8*)(V_lds + (b) * SHM_V + vst1) = sr_[i].vs1; const int kc = sc * 2;               \
    *(LAS bf16x8*)(K_lds + (b) * SHM_K + KSWZ(sr, kc)) = sr_[i].ks0;                       \
    *(LAS bf16x8*)(K_lds + (b) * SHM_K + KSWZ(32 + sr, kc)) = sr_[i].ks1; } while (0)
#define SWAIT() asm volatile("s_waitcnt vmcnt(4)" ::: "memory")
#define RESC(a) do { if (__any((a) < 1.f)) { if (hi == 0) al_l[r32] = (a); asm volatile("s_waitcnt lgkmcnt(0)" ::: "memory"); \
    _Pragma("unroll") for (int d = 0; d < 4; ++d) _Pragma("unroll") for (int r = 0; r < 16; ++r) o[d][r] *= al_l[crow(r, hi)]; } } while (0)
    f32x16 pA0, pA1, pB0, pB1; float mnA, mnB, alA, alB; bf16x8 pa0, pa1, pa2, pa3;
    constexpr int SE = 0, SO = 1;
    SLOAD(SE, 0); asm volatile("s_waitcnt vmcnt(0)" ::: "memory"); SWRITE(0, SE);
    SLOAD(SO, 1); if (2 < NT) SLOAD(SE, 2);
    __syncthreads();
    qkt(pA0, pA1, K_lds, qr, r32, hi, cofs); partialSM(pA0, pA1, m_reg, mnA, alA);
    SWAIT(); SWRITE(1, SO); __syncthreads();
    int bK = 1, bP = 0, bF = 2;
    for (int j = 1; j + 1 < NT; j += 2) {
        SBAR(); qkt(pB0, pB1, K_lds + bK * SHM_K, qr, r32, hi, cofs);
        finishSM(pA0, pA1, alA, l_reg, pa0, pa1, pa2, pa3); SBAR();
        SLOAD(SO, j + 2); SBAR();
        pv_d0(o, vb0 + bP * SHM_V, pa0, pa1, pa2, pa3); partialSM(pB0, pB1, m_reg, mnB, alB);
        SWAIT(); SWRITE(bF, SE);
        RESC(alB); __syncthreads();
        { const int t = bP; bP = bK; bK = bF; bF = t; }
        SBAR(); qkt(pA0, pA1, K_lds + bK * SHM_K, qr, r32, hi, cofs);
        finishSM(pB0, pB1, alB, l_reg, pa0, pa1, pa2, pa3); SBAR();
        if (j + 3 < NT) SLOAD(SE, j + 3); SBAR();
        pv_d0(o, vb0 + bP * SHM_V, pa0, pa1, pa2, pa3); partialSM(pA0, pA1, m_reg, mnA, alA);
        SWAIT(); SWRITE(bF, SO);
        RESC(alA); __syncthreads();
        { const int t = bP; bP = bK; bK = bF; bF = t; }
    }
    SBAR(); qkt(pB0, pB1, K_lds + bK * SHM_K, qr, r32, hi, cofs);
    finishSM(pA0, pA1, alA, l_reg, pa0, pa1, pa2, pa3); SBAR();
    pv_d0(o, vb0 + bP * SHM_V, pa0, pa1, pa2, pa3); partialSM(pB0, pB1, m_reg, mnB, alB);
    RESC(alB);
    finishSM(pB0, pB1, alB, l_reg, pa0, pa1, pa2, pa3); SBAR();
    pv_d0(o, vb0 + bK * SHM_V, pa0, pa1, pa2, pa3);
    if (hi == 0) li_l[r32] = l_reg;
    asm volatile("s_waitcnt vmcnt(0) lgkmcnt(0)" ::: "memory");
    __syncthreads();
    {
        LAS float* ex = (LAS float*)lds + (size_t)comp * 128 * EXS + (size_t)(wq * 32) * EXS;
        float rli[16];
#pragma unroll
        for (int r = 0; r < 16; ++r) rli[r] = 1.0f / li_l[crow(r, hi)];
#pragma unroll
        for (int r = 0; r < 16; ++r) { const int orow = crow(r, hi);
#pragma unroll
            for (int d0 = 0; d0 < 4; ++d0) ex[orow * EXS + d0 * 32 + r32] = o[d0][r] * rli[r]; }
    }
    __syncthreads();
    {
        const int row = tid >> 2, qt = tid & 3;
        const LAS float* e0 = (const LAS float*)lds + (size_t)row * EXS + qt * 32; const LAS float* e1 = e0 + 128 * EXS;
        f32x4 ov[8]; float ss = 0.f;
#pragma unroll
        for (int i = 0; i < 8; ++i) { const f32x4 a = *(const LAS f32x4*)(e0 + i * 4), b = *(const LAS f32x4*)(e1 + i * 4); ov[i] = a - b * lam;
            ss += ov[i][0] * ov[i][0] + ov[i][1] * ov[i][1] + ov[i][2] * ov[i][2] + ov[i][3] * ov[i][3]; }
        ss += __shfl_xor(ss, 1); ss += __shfl_xor(ss, 2);
        const float rs = rsqrtf(ss * (1.0f / 128.0f) + EPS) * oscale;
#if WO_FP8
        unsigned char* op = (unsigned char*)AOb + (size_t)(qrow0 + row) * D + h * 128 + qt * 32;
        const float rs8 = rs * A8_SCALE; unsigned wq[8];
#pragma unroll
        for (int i = 0; i < 4; ++i) { const f32x4 g0 = *(const f32x4*)(subg + qt * 32 + i * 8), g1 = *(const f32x4*)(subg + qt * 32 + i * 8 + 4);
            const f32x4 a = ov[2 * i] * rs8 * g0, b = ov[2 * i + 1] * rs8 * g1;
            wq[2 * i] = pk4_fp8(a[0], a[1], a[2], a[3]); wq[2 * i + 1] = pk4_fp8(b[0], b[1], b[2], b[3]); }
        { u32x4 w0, w1; w0.x = wq[0]; w0.y = wq[1]; w0.z = wq[2]; w0.w = wq[3]; w1.x = wq[4]; w1.y = wq[5]; w1.z = wq[6]; w1.w = wq[7]; *(u32x4*)op = w0; *(u32x4*)(op + 16) = w1; }
#else
        bf16_t* op = AOb + (size_t)(qrow0 + row) * D + h * 128 + qt * 32;
#pragma unroll
        for (int i = 0; i < 4; ++i) { const f32x4 g0 = *(const f32x4*)(subg + qt * 32 + i * 8), g1 = *(const f32x4*)(subg + qt * 32 + i * 8 + 4);
            const f32x4 a = ov[2 * i] * rs * g0, b = ov[2 * i + 1] * rs * g1;
            u32x4 w; w.x = cvt_pk_bf16(a[0], a[1]); w.y = cvt_pk_bf16(a[2], a[3]); w.z = cvt_pk_bf16(b[0], b[1]); w.w = cvt_pk_bf16(b[2], b[3]);
            *(u32x4*)(op + i * 8) = w; }
#endif
    }
    __syncthreads();
#undef KROW
#undef SLOAD
#undef SWRITE
#undef SWAIT
#undef RESC
}
}

__device__ __forceinline__ void p_attention(const Ctx& F, const int j, const int Gc, const int vcu) {
    const float* lv = (const float*)(F.ws + WS_LAM); const float lam = lv[j * 2], oscale = lv[j * 2 + 1];
    const float* subg = F.in[15] + j * 128;
    LAS char* lds = (LAS char*)(F.lds + LDS_SCR);
    for (int i = 0;; ++i) {
        const int U = i * Gc + vcu; if (U >= 2048 + 256) break;
        if (U < 2048) { const int b = U >> 7, rem = U & 127, h = rem >> 4, qb = rem & 15;
            att::unit(F.QKV(), F.AO(), b * 2048 + qb * 128, h, b * 2048, 32, NLAT + b * 256, 36, lam, oscale, subg, lds, F.wave); }
        else { const int q = U - 2048, b = q >> 4, rem = q & 15, h = rem >> 1, qb = rem & 1;
            att::unit(F.QKV(), F.AO(), NLAT + b * 256 + qb * 128, h, 0, 0, NLAT + b * 256, 4, lam, oscale, subg, lds, F.wave); }
    }
}

template <int CTRL> __device__ __forceinline__ float dppz(float x) { return __builtin_bit_cast(float, __builtin_amdgcn_update_dpp(0, __builtin_bit_cast(int, x), CTRL, 0xF, 0xF, true)); }
struct S5K { float ar, as, br, bs, cr, cs, dr, ds, pr, ps; };
__device__ __forceinline__ float s5_swp(float x) { return dppz<0xB1>(x); }
template <int DIR> __device__ __forceinline__ void s5_scan2(const f32x4 E, float& R, const S5K& k, const int lane, float (&xin)[4]) {
#define IX(j) (DIR == 0 ? (j) : 3 - (j))
    float z = E[IX(0)];
    z = fmaf(k.ar, z, fmaf(k.as, s5_swp(z), E[IX(1)])); z = fmaf(k.ar, z, fmaf(k.as, s5_swp(z), E[IX(2)])); z = fmaf(k.ar, z, fmaf(k.as, s5_swp(z), E[IX(3)]));
    const int pq = lane >> 4, gp = DIR == 0 ? pq : 3 - pq;
    const int s1 = DIR == 0 ? lane - 16 : lane + 16, s2 = DIR == 0 ? lane - 32 : lane + 32;
    float S = z, t;
    t = __shfl(S, s1); t = gp >= 1 ? t : 0.f; S = fmaf(k.br, t, fmaf(k.bs, s5_swp(t), S));
    t = __shfl(S, s2); t = gp >= 2 ? t : 0.f; S = fmaf(k.cr, t, fmaf(k.cs, s5_swp(t), S));
    t = __shfl(S, s1); t = gp >= 1 ? t : 0.f;
    const float Ro = s5_swp(R);
    float c = fmaf(k.pr, R, fmaf(k.ps, Ro, t));
    const float sl = __shfl(S, (DIR == 0 ? 48 : 0) + (lane & 15));
    R = fmaf(k.dr, R, fmaf(k.ds, Ro, sl));
    xin[IX(0)] = c;
    c = fmaf(k.ar, c, fmaf(k.as, s5_swp(c), E[IX(0)])); xin[IX(1)] = c;
    c = fmaf(k.ar, c, fmaf(k.as, s5_swp(c), E[IX(1)])); xin[IX(2)] = c;
    c = fmaf(k.ar, c, fmaf(k.as, s5_swp(c), E[IX(2)])); xin[IX(3)] = c;
#undef IX
}
__device__ __forceinline__ S5K s5_consts(const float* ab, const int comp, const int gp) {
    float r = ab[0], i = ab[1];
#define CSQ() { const float nr = r * r - i * i, ni = 2.f * r * i; r = nr; i = ni; }
    CSQ() CSQ() CSQ() CSQ()
    S5K k; const float sg = comp ? 1.f : -1.f;
    k.ar = r; k.as = sg * i;
    CSQ() CSQ()
    const float b_r = r, b_i = i; k.br = r; k.bs = sg * i;
    CSQ()
    const float c_r = r, c_i = i; k.cr = r; k.cs = sg * i;
    CSQ()
    k.dr = r; k.ds = sg * i;
#undef CSQ
    const float e_r = b_r * c_r - b_i * c_i, e_i = b_r * c_i + b_i * c_r;
    const float p_r = gp == 0 ? 1.f : gp == 1 ? b_r : gp == 2 ? c_r : e_r, p_i = gp == 0 ? 0.f : gp == 1 ? b_i : gp == 2 ? c_i : e_i;
    k.pr = p_r; k.ps = sg * p_i;
    return k;
}
__device__ __forceinline__ void p_s5ssd(const Ctx& F, const int j2, const bool ctx_out) {
    const int lane = F.lane, w = F.wave;
    LAS char* UL = (LAS char*)(F.lds + LDS_SCR);
    LAS char* XL = UL + 144 * 528;
#pragma unroll 1
    for (int item = F.blk; item < 256; item += F.G) {
        const int g = 8 * (item & 7) + (item >> 5), bq = (item >> 3) & 3, it = j2 * 64 + g;
        int lane1 = lane, tid1 = F.tid; asm volatile("" : "+v"(lane1), "+v"(tid1));
        const int l16 = lane1 & 15, pq = lane1 >> 4;
        u32x4 pre[9];
#define S5_PRELOAD(bb) { const bf16_t* Hb = F.H(); _Pragma("unroll") for (int i = 0; i < 9; ++i) { const int idx = tid1 + 512 * i, ti = idx >> 1, hf = idx & 1; \
            const size_t row = ti < 256 ? (size_t)(NLAT + (bb) * 256 + ti) : (size_t)((bb) * 2048 + ti - 256); pre[i] = *(const u32x4*)(Hb + row * D + g * 16 + hf * 8); } }
        S5_PRELOAD(bq * 4)
        const S5K kf = s5_consts((const float*)(F.ws + WS_S5AB) + ((size_t)((j2 * 2 + 0) * 64 + g) * 64 + 8 * w + (l16 >> 1)) * 2, l16 & 1, pq);
        const S5K kb = s5_consts((const float*)(F.ws + WS_S5AB) + ((size_t)((j2 * 2 + 1) * 64 + g) * 64 + 8 * w + (l16 >> 1)) * 2, l16 & 1, 3 - pq);
#pragma unroll 1
        for (int bi = 0; bi < 4; ++bi) {
            const int b = bq * 4 + bi;
            int lane2 = lane1, tid2 = tid1; asm volatile("" : "+v"(lane2), "+v"(tid2));
            const int m16 = lane2 & 15, mq = lane2 >> 4;
            bf16x8 Wf[8], Wb[8];
            { const bf16x8* tp = (const bf16x8*)(F.ws + WS_S5T1 + (size_t)it * 131072) + (size_t)(w * 8) * 64 + lane2;
#pragma unroll
              for (int kk = 0; kk < 8; ++kk) { Wf[kk] = tp[kk * 64]; Wb[kk] = tp[(64 + kk) * 64]; } }
            __syncthreads();
#pragma unroll
            for (int i = 0; i < 9; ++i) { const int idx = tid2 + 512 * i, ti = idx >> 1, hf = idx & 1; *(LAS u32x4*)(UL + (ti >> 4) * 528 + (ti & 15) * 32 + hf * 16) = pre[i]; }
            __syncthreads();
            if (bi < 3) S5_PRELOAD(b + 1)
            {
                float R = 0.f;
#pragma unroll 9
                for (int q = 0; q < 9; ++q) {
                    const int mt = q == 0 ? 0 : 9 - q;
                    f32x4 e0 = {0.f, 0.f, 0.f, 0.f}, e1 = {0.f, 0.f, 0.f, 0.f};
#pragma unroll
                    for (int kk = 0; kk < 8; kk += 2) {
                        const bf16x8 u0 = *(const LAS bf16x8*)(UL + (mt * 16 + m16) * 528 + kk * 64 + mq * 16), u1 = *(const LAS bf16x8*)(UL + (mt * 16 + m16) * 528 + (kk + 1) * 64 + mq * 16);
                        e0 = __builtin_amdgcn_mfma_f32_16x16x32_bf16(u0, Wb[kk], e0, 0, 0, 0); e1 = __builtin_amdgcn_mfma_f32_16x16x32_bf16(u1, Wb[kk + 1], e1, 0, 0, 0); }
                    float xin[4]; s5_scan2<1>(e0 + e1, R, kb, lane2, xin);
                    LAS char* xp = XL + (mt * 16 + 4 * mq) * 528 + (128 + 16 * w + m16) * 2;
#pragma unroll
                    for (int i = 0; i < 4; ++i) *(LAS unsigned short*)(xp + i * 528) = (unsigned short)cvt_pk_bf16(xin[i], xin[i]);
                }
            }
            {
                float R = 0.f;
#pragma unroll 9
                for (int mt = 0; mt < 9; ++mt) {
                    f32x4 e0 = {0.f, 0.f, 0.f, 0.f}, e1 = {0.f, 0.f, 0.f, 0.f};
#pragma unroll
                    for (int kk = 0; kk < 8; kk += 2) {
                        const bf16x8 u0 = *(const LAS bf16x8*)(UL + (mt * 16 + m16) * 528 + kk * 64 + mq * 16), u1 = *(const LAS bf16x8*)(UL + (mt * 16 + m16) * 528 + (kk + 1) * 64 + mq * 16);
                        e0 = __builtin_amdgcn_mfma_f32_16x16x32_bf16(u0, Wf[kk], e0, 0, 0, 0); e1 = __builtin_amdgcn_mfma_f32_16x16x32_bf16(u1, Wf[kk + 1], e1, 0, 0, 0); }
                    float xin[4]; s5_scan2<0>(e0 + e1, R, kf, lane2, xin);
                    LAS char* xp = XL + (mt * 16 + 4 * mq) * 528 + (16 * w + m16) * 2;
#pragma unroll
                    for (int i = 0; i < 4; ++i) *(LAS unsigned short*)(xp + i * 528) = (unsigned short)cvt_pk_bf16(xin[i], xin[i]);
                }
            }
            bf16x8 T3[2][16];
            { const bf16x8* tp = (const bf16x8*)(F.ws + WS_S5T3 + (size_t)it * 262144) + (size_t)(w * 32) * 64 + lane2;
#pragma unroll
              for (int tt = 0; tt < 2; ++tt)
#pragma unroll
                  for (int kk = 0; kk < 16; ++kk) T3[tt][kk] = tp[(tt * 16 + kk) * 64]; }
            __syncthreads();
#pragma unroll 1
            for (int mt = ctx_out ? 0 : 1; mt < 9; ++mt) {
                const LAS char* ub = UL + (mt * 16 + m16) * 528 + mq * 16;
                f32x4 y0 = {0.f, 0.f, 0.f, 0.f}, y1 = {0.f, 0.f, 0.f, 0.f};
#pragma unroll
                for (int kk = 0; kk < 8; ++kk) { const bf16x8 v = *(const LAS bf16x8*)(ub + kk * 64);
                    y0 = __builtin_amdgcn_mfma_f32_16x16x32_bf16(T3[0][kk], v, y0, 0, 0, 0); y1 = __builtin_amdgcn_mfma_f32_16x16x32_bf16(T3[1][kk], v, y1, 0, 0, 0); }
#pragma unroll
                for (int kk = 0; kk < 8; ++kk) { const bf16x8 v = *(const LAS bf16x8*)(ub + 144 * 528 + kk * 64);
                    y0 = __builtin_amdgcn_mfma_f32_16x16x32_bf16(T3[0][8 + kk], v, y0, 0, 0, 0); y1 = __builtin_amdgcn_mfma_f32_16x16x32_bf16(T3[1][8 + kk], v, y1, 0, 0, 0); }
                const size_t tok = (mt == 0 ? (size_t)(NLAT + b * 256 + m16 * 16) : (size_t)(b * 2048 + ((mt - 1) * 16 + m16) * 16)) + 2 * w;
#if GLU_FP8
                unsigned char* op = (unsigned char*)F.AO() + tok * D + g * 16 + mq * 4;
                *(unsigned*)op = pk4_fp8(gelu_tanh(y0[0]) * A8_SCALE, gelu_tanh(y0[1]) * A8_SCALE, gelu_tanh(y0[2]) * A8_SCALE, gelu_tanh(y0[3]) * A8_SCALE);
                *(unsigned*)(op + D) = pk4_fp8(gelu_tanh(y1[0]) * A8_SCALE, gelu_tanh(y1[1]) * A8_SCALE, gelu_tanh(y1[2]) * A8_SCALE, gelu_tanh(y1[3]) * A8_SCALE);
#else
                bf16_t* op = F.AO() + tok * D + g * 16 + mq * 4;
                u32x2 o0, o1; o0.x = cvt_pk_bf16(gelu_tanh(y0[0]), gelu_tanh(y0[1])); o0.y = cvt_pk_bf16(gelu_tanh(y0[2]), gelu_tanh(y0[3]));
                o1.x = cvt_pk_bf16(gelu_tanh(y1[0]), gelu_tanh(y1[1])); o1.y = cvt_pk_bf16(gelu_tanh(y1[2]), gelu_tanh(y1[3]));
                *(u32x2*)op = o0; *(u32x2*)(op + D) = o1;
#endif
            }
        }
#undef S5_PRELOAD
    }
    __syncthreads();
}

typedef const __attribute__((address_space(4))) Args* KArgs;
__device__ __forceinline__ Ctx make_ctx(int wave0, int blk0) {
    extern __shared__ __attribute__((aligned(16))) unsigned char lds_raw[];
    unsigned long long kp = (unsigned long long)(uintptr_t)(const void*)__builtin_amdgcn_kernarg_segment_ptr();
    asm volatile("" : "+s"(kp));
    KArgs A = (KArgs)(uintptr_t)kp;
    int lane; asm volatile("v_mbcnt_lo_u32_b32 %0, -1, 0\n\tv_mbcnt_hi_u32_b32 %0, -1, %0" : "=v"(lane));
    asm volatile("" : "+s"(wave0)); asm volatile("" : "+s"(blk0));
    Ctx F; F.in = (const float* const*)A->in; F.out = A->out; F.ws = A->ws; F.lds = (LAS unsigned char*)lds_raw;
    F.lane = lane; F.wave = wave0; F.tid = wave0 * 64 + lane; F.blk = blk0; F.G = gridDim.x;
    F.vcu = (F.G % 8 == 0) ? (F.blk % 8) * (F.G / 8) + F.blk / 8 : F.blk;
    F.split = (F.G % 128 == 0) ? 1 : 0;
    { const int x = F.blk & 7, li = F.blk >> 3, r = li & 15; F.conv = F.split && ((r % 5) == 4); const int below = (li >> 4) * 3 + r / 5;
      F.cblk = (li - below) * 8 + x; F.cG = F.G - (F.G >> 4) * 3; F.vblk = below * 8 + x; F.vG = (F.G >> 4) * 3; }
    return F;
}
#define MKCTX() make_ctx(wave0, blk0)
__device__ __forceinline__ void ph_prologue(int wave0, int blk0) { const Ctx F = MKCTX(); p_prologue(F); }
__device__ __forceinline__ void ph_R(int layer, int wave0, int blk0) { layer = __builtin_amdgcn_readfirstlane(layer); const Ctx F = MKCTX(); p_rows_R(F, layer); }
#define CONV_COUNT(F) ((CV_GU + CV_D + (F).vG - 1 - (F).vblk) / (F).vG)
__device__ __forceinline__ void ph_qkv(int layer, int wave0, int blk0) { layer = __builtin_amdgcn_readfirstlane(layer); const Ctx F = MKCTX(); const int j = layer >> 1;
    const bool sp0 = F.split && layer == 0;
    if (sp0 && F.conv) { const int cnt = CONV_COUNT(F); p_convert_fp8(F, F.vblk, F.vG, 0, cnt * 22 / 100); return; }
    ProbQKV P; P.A = F.H(); P.Bt = (const bf16_t*)(F.ws + WS_WQKV) + (size_t)j * 3072 * 1024; P.O = F.QKV(); P.rope = (const float*)(F.ws + WS_ROPE);
    P.ord.init(144, 12, sp0 ? F.cG : F.G, sp0 ? F.cblk : F.blk); pg8::gemm_phase(F.lds + LDS_SCR, P, F.tid); }
__device__ __forceinline__ void ph_attn(int layer, int wave0, int blk0) { layer = __builtin_amdgcn_readfirstlane(layer); const Ctx F = MKCTX();
    const bool sp0 = F.split && layer == 0;
    if (sp0 && F.conv) { const int cnt = CONV_COUNT(F); p_convert_fp8(F, F.vblk, F.vG, cnt * 22 / 100, cnt * 88 / 100); return; }
    const int Gc = sp0 ? F.cG : F.G, vc = sp0 ? (F.cblk & 7) * (F.cG >> 3) + (F.cblk >> 3) : F.vcu;
    p_attention(F, layer >> 1, Gc, vc); }
__device__ __forceinline__ void ph_wo(int layer, int wave0, int blk0) { layer = __builtin_amdgcn_readfirstlane(layer); const Ctx F = MKCTX(); const int j = layer >> 1;
    const bool sp0 = F.split && layer == 0;
    if (sp0 && F.conv) { const int cnt = CONV_COUNT(F); p_convert_fp8(F, F.vblk, F.vG, cnt * 88 / 100, cnt); return; }
    ProbResid<false> P; P.A = (const unsigned char*)F.AO(); P.Bt = F.ws + WS_WO + (size_t)j * 1024 * 1024 * (WO_FP8 ? 1 : 2); P.X = F.XB(); P.Xlat = F.in[0]; P.Xctx = F.in[2]; P.in_f32 = (layer == 0); P.gate = F.mod() + (size_t)layer * 17 * NMOD + 2 * D;
    P.ord.init(144, 4, sp0 ? F.cG : F.G, sp0 ? F.cblk : F.blk); if constexpr (WO_FP8) pg8::gemm_phase8(F.lds + LDS_SCR, P, F.tid); else pg8::gemm_phase(F.lds + LDS_SCR, P, F.tid); }
__device__ __forceinline__ void ph_scan(int layer, int wave0, int blk0) { layer = __builtin_amdgcn_readfirstlane(layer); const Ctx F = MKCTX(); p_s5ssd(F, layer >> 1, layer < 3); }
__device__ __forceinline__ void ph_glu(int layer, int wave0, int blk0) { layer = __builtin_amdgcn_readfirstlane(layer); const Ctx F = MKCTX(); const int j = layer >> 1;
    ProbResid<true> P; P.A = (const unsigned char*)F.AO(); P.Bt = F.ws + WS_WGLU + (size_t)j * 2048 * 1024 * (GLU_FP8 ? 1 : 2); P.X = F.XB(); P.Xlat = F.in[0]; P.Xctx = F.in[2]; P.in_f32 = false; P.gate = F.mod() + (size_t)layer * 17 * NMOD + 2 * D;
    P.ord.init(layer < 3 ? 144 : 128, 8, F.G, F.blk); if constexpr (GLU_FP8) pg8::gemm_phase8(F.lds + LDS_SCR, P, F.tid); else pg8::gemm_phase(F.lds + LDS_SCR, P, F.tid); }
__device__ __forceinline__ void ph_m1(int layer, int wave0, int blk0) { layer = __builtin_amdgcn_readfirstlane(layer); const Ctx F = MKCTX(); p_rows_M1(F, layer); }
__device__ __forceinline__ void ph_topk(int layer, int wave0, int blk0) { layer = __builtin_amdgcn_readfirstlane(layer); const Ctx F = MKCTX(); p_topk(F, layer); }
__device__ __forceinline__ void ph_moe1(int layer, int wave0, int blk0) { layer = __builtin_amdgcn_readfirstlane(layer); const Ctx F = MKCTX();
    ProbMoe1 P; P.A = F.H2Q(); P.Bt = F.ws + WS_WGU + (size_t)layer * 16 * 4096 * 1024; P.O = (void*)(F.ws + WS_BIG); P.midx = F.MIDX();
    P.ord.init(layer < 3 ? 18 : 16, 16, F.G, F.blk); pg8::gemm_phase8(F.lds + LDS_SCR, P, F.tid); }
__device__ __forceinline__ void ph_moe2(int layer, int wave0, int blk0) { layer = __builtin_amdgcn_readfirstlane(layer); const Ctx F = MKCTX();
    ProbMoe2 P; P.A = (const void*)(F.ws + WS_BIG); P.O = F.Y();
#if MOE2_FP8
    P.Bt = (const void*)(F.ws + WS_WD + (size_t)layer * 16 * 1024 * 2048);
    P.ord.init(layer < 3 ? 18 : 16, 4, F.G, F.blk); pg8::gemm_phase8(F.lds + LDS_SCR, P, F.tid);
    if (F.G == 256 && layer < 2 && (F.blk >> 3) >= 16) { const int ii = ((F.blk >> 3) - 16) * 8 + (F.blk & 7); p_s5tables(F, layer * 128 + ii, 128, layer * 128 + 128); }
#else
    P.Bt = (const void*)((const bf16_t*)(F.ws + WS_WD) + (size_t)layer * 16 * 1024 * 2048);
    P.ord.init(layer < 3 ? 18 : 16, 4, F.G, F.blk); pg8::gemm_phase(F.lds + LDS_SCR, P, F.tid);
#endif
}

constexpr int NPH = 34;
__global__ void __launch_bounds__(512, 2) mk_fwd(Args args) {
    extern __shared__ __attribute__((aligned(16))) unsigned char lds_raw[];
    const int lo = args.ph_lo, hi = args.ph_hi;
    const int wave0 = __builtin_amdgcn_readfirstlane(threadIdx.x >> 6), blk0 = __builtin_amdgcn_readfirstlane(blockIdx.x);
#if ONE_LAUNCH
    if (threadIdx.x < 4) ((LAS unsigned*)lds_raw)[threadIdx.x] = 0u;
    __syncthreads();
    XcdBarrier bar = xcd_barrier_post((unsigned*)(args.ws + WS_CTL), (volatile LAS unsigned*)lds_raw);
#define GRID_BAR() xcd_barrier(bar)
#else
#define GRID_BAR() do { } while (0)
#endif
#ifndef PHM
#define PHM 0xFFFF
#endif
#define PHS(b) ((PHM >> (b)) & 1)
#define IN(k) (lo <= (k) && (k) < hi)
#define SEAM(k) do { if (IN((k) + 1)) GRID_BAR(); } while (0)
    if (PHS(0) && IN(0)) { ph_prologue(wave0, blk0); SEAM(0); }
    for (int layer = 0; layer < 4; ++layer) {
        const int pb = 1 + 8 * layer;
        if (PHS(1) && IN(pb + 0)) { ph_R(layer, wave0, blk0); SEAM(pb + 0); }
        if ((layer & 1) == 0) {
            if (PHS(2) && IN(pb + 1)) { ph_qkv(layer, wave0, blk0); SEAM(pb + 1); }
            if (PHS(3) && IN(pb + 2)) { ph_attn(layer, wave0, blk0); SEAM(pb + 2); }
            if (PHS(4) && IN(pb + 3)) { ph_wo(layer, wave0, blk0); SEAM(pb + 3); }
        } else {
            if (PHS(5) && IN(pb + 1)) { ph_scan(layer, wave0, blk0); SEAM(pb + 1); }
            if (PHS(6) && IN(pb + 2)) { ph_glu(layer, wave0, blk0); SEAM(pb + 3); }
        }
        if (PHS(7) && IN(pb + 4)) { ph_m1(layer, wave0, blk0); SEAM(pb + 4); }
        if (PHS(8) && IN(pb + 5)) { ph_topk(layer, wave0, blk0); SEAM(pb + 5); }
        if (PHS(9) && IN(pb + 6)) { ph_moe1(layer, wave0, blk0); SEAM(pb + 6); }
        if (PHS(10) && IN(pb + 7)) { ph_moe2(layer, wave0, blk0); SEAM(pb + 7); }
    }
    if (PHS(1) && IN(33)) ph_R(4, wave0, blk0);
#undef IN
#undef SEAM
}

extern "C" void kernel_launch(void* const* d_in, const int* in_sizes, int n_in, void* d_out, int out_size, void* d_ws, size_t ws_size, hipStream_t stream) {
    static int grid = 0;
    if (grid == 0) {
        if (n_in != 31 || out_size != NLAT * D || ws_size < WS_END) { fprintf(stderr, "kernel_launch: unexpected shapes: n_in %d out %d ws %zu (need %zu)\n", n_in, out_size, ws_size, (size_t)WS_END); grid = -1; return; }
        int dev = 0, cus = 0, per_cu = 0;
        if (hipGetDevice(&dev) != hipSuccess || hipDeviceGetAttribute(&cus, hipDeviceAttributeMultiprocessorCount, dev) != hipSuccess) { grid = -1; return; }
        if (hipFuncSetAttribute((const void*)mk_fwd, hipFuncAttributeMaxDynamicSharedMemorySize, LDS_BYTES) != hipSuccess) { fprintf(stderr, "kernel_launch: hipFuncSetAttribute failed\n"); grid = -1; return; }
        if (hipOccupancyMaxActiveBlocksPerMultiprocessor(&per_cu, (const void*)mk_fwd, 512, LDS_BYTES) != hipSuccess || per_cu < 1) { fprintf(stderr, "kernel_launch: occupancy query says %d\n", per_cu); }
        (void)hipGetLastError();
        grid = cus;
    }
    if (grid < 0) return;
    (void)in_sizes;
    Args a{};
    for (int i = 0; i < 31; ++i) a.in[i] = (const float*)d_in[i];
    a.out = (float*)d_out; a.ws = (unsigned char*)d_ws;
#if ONE_LAUNCH
    (void)hipMemsetAsync((char*)d_ws + WS_CTL, 0, 65536, stream);
    a.ph_lo = 0; a.ph_hi = NPH;
    hipLaunchKernelGGL(mk_fwd, dim3(grid), dim3(512), LDS_BYTES, stream, a);
#else
    for (int ph = 0; ph < NPH; ++ph) {
        if (ph >= 1 && ph <= 32) { const int layer = (ph - 1) / 8, slot = (ph - 1) % 8; if ((layer & 1) == 1 && slot == 3) continue; }
        a.ph_lo = ph; a.ph_hi = ph + 1;
        hipLaunchKernelGGL(mk_fwd, dim3(grid), dim3(512), LDS_BYTES, stream, a);
    }
#endif
    const hipError_t le = hipPeekAtLastError();
    if (le != hipSuccess) fprintf(stderr, "kernel_launch: launch failed: %s\n", hipGetErrorName(le));
}
```

```cpp
#include <hip/hip_runtime.h>
#include <cstdio>
#include <cstdint>

#ifndef ONE_LAUNCH
#define ONE_LAUNCH 1
#endif
#ifndef WO_FP8
#define WO_FP8 0
#endif
#ifndef GLU_FP8
#define GLU_FP8 1
#endif
#ifndef MOE2_FP8
#define MOE2_FP8 1
#endif

#define LAS __attribute__((address_space(3)))
typedef unsigned short bf16_t;
typedef short bf16x8 __attribute__((ext_vector_type(8)));
typedef short s16x4 __attribute__((ext_vector_type(4)));
typedef float f32x4 __attribute__((ext_vector_type(4)));
typedef float f32x2 __attribute__((ext_vector_type(2)));
typedef float f32x16 __attribute__((ext_vector_type(16)));
typedef unsigned u32x4 __attribute__((ext_vector_type(4)));
typedef unsigned u32x2 __attribute__((ext_vector_type(2)));
typedef int i32x8 __attribute__((ext_vector_type(8)));

constexpr int D = 1024, NB = 16, SEQ = 2048, LC = 256, NLAT = NB * SEQ, NCTX = NB * LC, NTOK = NLAT + NCTX;
constexpr int NE = 16, FF = 2048, EROWS = 4608, NMOD = 6 * D;
constexpr float EPS = 1e-6f;

constexpr size_t al256(size_t x) { return (x + 255) / 256 * 256; }
constexpr size_t WS_CTL = 0;
constexpr size_t WS_MOD = 65536;
constexpr size_t WS_ROPE = WS_MOD + al256((size_t)4 * 17 * NMOD * 4);
constexpr size_t WS_S5BB = WS_ROPE + (size_t)2048 * 32 * 2 * 4;
constexpr size_t WS_S5CT = WS_S5BB + (size_t)256 * 4096;
constexpr size_t WS_S5AB = WS_S5CT + (size_t)256 * 4096;
constexpr size_t WS_LAM = WS_S5AB + (size_t)256 * 64 * 2 * 4;
constexpr size_t WS_AFF = WS_LAM + 256;
constexpr size_t WS_SEL = WS_AFF + (size_t)NTOK * 16 * 4;
constexpr size_t WS_MIDX = WS_SEL + (size_t)NTOK * 16 * 4;
constexpr size_t WS_X = WS_MIDX + al256((size_t)NE * EROWS * 4);
constexpr size_t WS_H = WS_X + (size_t)NTOK * D * 4;
constexpr size_t WS_H2 = WS_H + (size_t)NTOK * D * 2;
constexpr size_t WS_AO = WS_H2 + (size_t)NTOK * D * 2;
constexpr size_t WS_BIG = WS_AO + (size_t)NTOK * D * 2;
constexpr size_t WS_Y = WS_BIG + (size_t)NE * EROWS * FF * 2;
constexpr size_t WS_WQKV = WS_Y + (size_t)NE * EROWS * D * 2;
constexpr size_t WS_WO = WS_WQKV + (size_t)2 * 3072 * D * 2;
constexpr size_t WS_WGLU = WS_WO + (size_t)2 * D * D * 2;
constexpr size_t WS_WGU = WS_WGLU + (size_t)2 * 2048 * D * 2;
constexpr size_t WS_WD = WS_WGU + (size_t)64 * 4096 * D * 2;
constexpr size_t WS_H2Q = WS_WD + (size_t)64 * D * FF * 2;
constexpr size_t WS_SH = WS_H2Q + (size_t)NTOK * D;
constexpr size_t WS_END = WS_SH + (size_t)NTOK * 4;
constexpr size_t WS_S5T3 = WS_WGU + (size_t)64 * 4096 * D;
constexpr size_t WS_S5T1 = WS_S5T3 + (size_t)128 * 262144;
static_assert(WS_S5T1 + (size_t)128 * 131072 <= WS_WD, "S5 tables fit");
static_assert((size_t)NTOK * 3072 * 2 <= (size_t)NE * EROWS * FF * 2, "QKV fits BIG");
static_assert((size_t)1024 * 2304 * 16 * 4 <= (size_t)NE * EROWS * FF * 2, "SP fits BIG");

constexpr int LDS_BYTES = 163840;
constexpr int LDS_SCR = 1024;

#define XB_TMO      128
#define XB_XCNT(j)  (256  + 64 * (j))
#define XB_XSUB(j)  (1280 + 64 * (j))
#define XB_XGEN(j)  (2304 + 64 * (j))
#define XB_TOP      3328
#define XB_TOPGEN   3392
#define XCD_BAR_WORDS 3456
#define XB_SPIN_CAP (1u << 18)

__device__ __forceinline__ unsigned xb_ld(unsigned* p)              { return __hip_atomic_load(p, __ATOMIC_RELAXED, __HIP_MEMORY_SCOPE_AGENT); }
__device__ __forceinline__ unsigned xb_add(unsigned* p, unsigned v) { return __hip_atomic_fetch_add(p, v, __ATOMIC_RELAXED, __HIP_MEMORY_SCOPE_AGENT); }
__device__ __forceinline__ unsigned xb_xcc_id() { return (unsigned)__builtin_amdgcn_s_getreg((3 << 11) | 20) & 0xFu; }
#define XB_SPIN(cond, bar) do { unsigned _sp = 0; while (cond) { __builtin_amdgcn_s_sleep(1); \
    if ((++_sp & 255u) == 0u) { if (xb_ld(&(bar)[XB_TMO])) break; if (_sp > XB_SPIN_CAP) { atomicAdd(&(bar)[XB_TMO], 1u); break; } } } } while (0)

struct XcdBarrier { unsigned* bar; unsigned x; volatile LAS unsigned* st; };

__device__ __forceinline__ XcdBarrier xcd_barrier_post(unsigned* bar, volatile LAS unsigned* st) {
    XcdBarrier b; b.bar = bar; b.x = xb_xcc_id(); b.st = st;
    if (threadIdx.x == 0) (void)xb_add(&bar[XB_XCNT(b.x)], 1u);
    return b;
}
__device__ __forceinline__ void xcd_barrier_complete(unsigned* bar, unsigned x, unsigned& nloc, unsigned& nx) {
    const unsigned G = gridDim.x * gridDim.y * gridDim.z;
    unsigned sum, cnt, mine, sp = 0u;
    for (;;) {
        sum = 0u; cnt = 0u; mine = 0u;
#pragma unroll
        for (unsigned j = 0; j < 16; ++j) { const unsigned c = xb_ld(&bar[XB_XCNT(j)]); sum += c; cnt += (c > 0u) ? 1u : 0u; mine = (j == x) ? c : mine; }
        if (sum == G) break;
        __builtin_amdgcn_s_sleep(1);
        if ((++sp & 255u) == 0u) { if (xb_ld(&bar[XB_TMO])) break; if (sp > XB_SPIN_CAP) { atomicAdd(&bar[XB_TMO], 1u); break; } }
    }
    nloc = mine > 0u ? mine : 1u; nx = cnt > 0u ? cnt : 1u;
}
__device__ __forceinline__ void xcd_barrier(const XcdBarrier& b) {
    asm volatile("s_waitcnt vmcnt(0)" ::: "memory");
    __syncthreads();
    if (threadIdx.x == 0) {
        unsigned* bar = b.bar;
        __builtin_amdgcn_s_waitcnt(0);
        unsigned nloc = b.st[0], nx = b.st[1];
        if (nloc == 0u) { xcd_barrier_complete(bar, b.x, nloc, nx); b.st[0] = nloc; b.st[1] = nx; }
        const unsigned old = xb_add(&bar[XB_XSUB(b.x)], 1u);
        const unsigned gen = old / nloc;
        if (old + 1u == (gen + 1u) * nloc) {
            __builtin_amdgcn_fence(__ATOMIC_RELEASE, "agent");
            asm volatile("s_waitcnt vmcnt(0)" ::: "memory");
            const unsigned og = xb_add(&bar[XB_TOP], 1u);
            const unsigned tg = og / nx;
            if (og + 1u == (tg + 1u) * nx) xb_add(&bar[XB_TOPGEN], 1u);
            else XB_SPIN(xb_ld(&bar[XB_TOPGEN]) == tg, bar);
            __builtin_amdgcn_fence(__ATOMIC_ACQUIRE, "agent");
            xb_add(&bar[XB_XGEN(b.x)], 1u);
            asm volatile("s_waitcnt vmcnt(0)" ::: "memory");
        } else {
            XB_SPIN(xb_ld(&bar[XB_XGEN(b.x)]) == gen, bar);
            __builtin_amdgcn_fence(__ATOMIC_ACQUIRE, "agent");
            asm volatile("s_waitcnt vmcnt(0)" ::: "memory");
        }
    }
    __syncthreads();
}

__device__ __forceinline__ unsigned cvt_pk_bf16(float lo, float hi) { unsigned r; asm volatile("v_cvt_pk_bf16_f32 %0, %1, %2" : "=v"(r) : "v"(lo), "v"(hi)); return r; }
constexpr float W8_SCALE = 2048.0f, W8_INV = 1.0f / 2048.0f;
constexpr float HID8_SCALE = 16.0f, HID8_INV = 1.0f / 16.0f;
constexpr float QSCALE = 0.125f * 1.4426950408889634f;
constexpr float Y8_SCALE = 64.0f, Y8_INV = 1.0f / 64.0f;
constexpr float A8_SCALE = 16.0f, A8_INV = 1.0f / 16.0f;
constexpr float H8_SCALE = 16.0f, H8_INV = 1.0f / 16.0f;
__device__ __forceinline__ float clamp448(float x) { return __builtin_amdgcn_fmed3f(x, -448.0f, 448.0f); }
__device__ __forceinline__ unsigned pk4_fp8(float a, float b, float c, float d) {
    int p = __builtin_amdgcn_cvt_pk_fp8_f32(clamp448(a), clamp448(b), 0, false);
    p = __builtin_amdgcn_cvt_pk_fp8_f32(clamp448(c), clamp448(d), p, true);
    return (unsigned)p;
}
__device__ __forceinline__ float bf_lo(unsigned w) { return __uint_as_float(w << 16); }
__device__ __forceinline__ float bf_hi(unsigned w) { return __uint_as_float(w & 0xffff0000u); }
__device__ __forceinline__ f32x4 bf4_unpack(u32x2 t) { return (f32x4){bf_lo(t.x), bf_hi(t.x), bf_lo(t.y), bf_hi(t.y)}; }
__device__ __forceinline__ u32x2 bf4_pack(f32x4 v) { u32x2 o; o.x = cvt_pk_bf16(v[0], v[1]); o.y = cvt_pk_bf16(v[2], v[3]); return o; }
__device__ __forceinline__ float wave_sum(float v) {
#pragma unroll
    for (int o = 32; o > 0; o >>= 1) v += __shfl_xor(v, o);
    return v;
}
__device__ __forceinline__ float sigmoidf_(float x) { return __builtin_amdgcn_rcpf(1.0f + __builtin_amdgcn_exp2f(x * -1.4426950408889634f)); }
__device__ __forceinline__ float siluf_(float x) { return x * sigmoidf_(x); }
__device__ __forceinline__ float gelu_tanh(float y) {
    const float z = y * fmaf(y * y, -0.10294324f, -2.3022082f); return y * __builtin_amdgcn_rcpf(1.0f + __builtin_amdgcn_exp2f(z)); }

struct Args { const float* in[31]; float* out; unsigned char* ws; int ph_lo, ph_hi; };

struct Ctx {
    const float* const* in; float* out; unsigned char* ws; LAS unsigned char* lds;
    int tid, lane, wave, blk, G, vcu;
    int split, conv, cblk, cG, vblk, vG;
    __device__ __forceinline__ float* mod() const { return (float*)(ws + WS_MOD); }
    __device__ __forceinline__ bf16_t* XB() const { return (bf16_t*)(ws + WS_X); }
    __device__ __forceinline__ bf16_t* H() const { return (bf16_t*)(ws + WS_H); }
    __device__ __forceinline__ bf16_t* H2() const { return (bf16_t*)(ws + WS_H2); }
    __device__ __forceinline__ bf16_t* AO() const { return (bf16_t*)(ws + WS_AO); }
    __device__ __forceinline__ bf16_t* QKV() const { return (bf16_t*)(ws + WS_BIG); }
    __device__ __forceinline__ bf16_t* HID() const { return (bf16_t*)(ws + WS_BIG); }
    __device__ __forceinline__ float* SP() const { return (float*)(ws + WS_BIG); }
    __device__ __forceinline__ bf16_t* Y() const { return (bf16_t*)(ws + WS_Y); }
    __device__ __forceinline__ float* AFF() const { return (float*)(ws + WS_AFF); }
    __device__ __forceinline__ int* SEL() const { return (int*)(ws + WS_SEL); }
    __device__ __forceinline__ int* MIDX() const { return (int*)(ws + WS_MIDX); }
    __device__ __forceinline__ unsigned char* H2Q() const { return ws + WS_H2Q; }
    __device__ __forceinline__ float* SH() const { return (float*)(ws + WS_SH); }
    __device__ __forceinline__ unsigned char* HID8() const { return ws + WS_BIG; }
};

__device__ __forceinline__ int qkv_colmap(int r) {
    if (r >= 2048) return r;
    const int sec = r >> 10, rr = r & 1023, hc = rr >> 6, jn = rr & 63, pr = jn >> 1, half = jn & 1, a = pr >> 4, f = pr & 15;
    return sec * 1024 + hc * 64 + a * 32 + half * 16 + f;
}
constexpr int CV_QKV = 2 * 24 * 8, CV_WO = 2 * 8 * 8, CV_GLU = 2 * 16 * 8, CV_GU = 64 * 32 * 8, CV_D = 64 * 8 * 16;
constexpr int CV_TOTAL = CV_QKV + CV_WO + CV_GLU + CV_GU + CV_D;


__device__ __forceinline__ void p_convert_fp8(const Ctx& F, const int first, const int stride, const int n_lo, const int n_hi) {
    LAS unsigned* T0 = (LAS unsigned*)(F.lds + LDS_SCR); LAS unsigned* T1 = T0 + 128 * 34;
    const int cg = F.tid & 31, kp = F.tid >> 5;
    const int orow = F.tid >> 2, kq = F.tid & 3;
#define CV8_DECODE(q, SRC, DST, NN, KK, R0, K0, C0) do { \
    if ((q) < CV_GU) { const int ie = (q) / 256, rem = (q) % 256; R0 = (rem >> 3) * 128; K0 = (rem & 7) * 128; NN = 2048; KK = 1024; \
        const int tile = R0 >> 8, half = (R0 >> 7) & 1; C0 = tile * 128; \
        SRC = (half ? F.in[29] : F.in[28]) + (size_t)ie * 1024 * 2048; DST = F.ws + WS_WGU + (size_t)ie * 4096 * 1024; } \
    else { const int qq = (q) - CV_GU, ie = qq / 128, rem = qq % 128; R0 = (rem >> 4) * 128; K0 = (rem & 15) * 128; NN = 1024; KK = 2048; C0 = R0; \
        SRC = F.in[30] + (size_t)ie * 2048 * 1024; DST = F.ws + WS_WD + (size_t)ie * 1024 * 2048; } } while (0)
#define CV8_LOAD(V, q) do { const float* src_; unsigned char* dst_; int N_, K_, r0_, k0_, c0_; CV8_DECODE(q, src_, dst_, N_, K_, r0_, k0_, c0_); (void)dst_; (void)K_; (void)r0_; \
    const float* sp_ = src_ + (size_t)(k0_ + 4 * kp) * N_ + c0_ + 4 * cg; \
    _Pragma("unroll") for (int p = 0; p < 2; ++p) _Pragma("unroll") for (int r = 0; r < 4; ++r) V[p][r] = *(const f32x4*)(sp_ + (size_t)(64 * p + r) * N_); } while (0)
#define CV8_PROC(V, q, TB) do { const float* src_; unsigned char* dst_; int N_, K_, r0_, k0_, c0_; CV8_DECODE(q, src_, dst_, N_, K_, r0_, k0_, c0_); (void)src_; (void)N_; (void)c0_; \
    _Pragma("unroll") for (int p = 0; p < 2; ++p) _Pragma("unroll") for (int c = 0; c < 4; ++c) \
        (TB)[(4 * cg + c) * 34 + kp + 16 * p] = pk4_fp8(V[p][0][c] * W8_SCALE, V[p][1][c] * W8_SCALE, V[p][2][c] * W8_SCALE, V[p][3][c] * W8_SCALE); \
    asm volatile("s_waitcnt lgkmcnt(0)" ::: "memory"); __builtin_amdgcn_s_barrier(); asm volatile("" ::: "memory"); \
    { const LAS u32x2* rp = (const LAS u32x2*)((TB) + orow * 34 + kq * 8); u32x4 o0, o1; u32x2 t0, t1; \
      t0 = rp[0]; t1 = rp[1]; o0.x = t0.x; o0.y = t0.y; o0.z = t1.x; o0.w = t1.y; \
      t0 = rp[2]; t1 = rp[3]; o1.x = t0.x; o1.y = t0.y; o1.z = t1.x; o1.w = t1.y; \
      u32x4* dp = (u32x4*)(dst_ + (size_t)(r0_ + orow) * K_ + k0_ + kq * 32); dp[0] = o0; dp[1] = o1; } } while (0)
    LAS unsigned* T2 = T1 + 128 * 34;
    f32x4 vA[2][4], vB[2][4], vC[2][4];
    if (n_lo < n_hi) CV8_LOAD(vA, first + n_lo * stride);
    if (n_lo + 1 < n_hi) CV8_LOAD(vB, first + (n_lo + 1) * stride);
#pragma unroll 1
    for (int n = n_lo; n < n_hi; n += 3) {
        if (n + 2 < n_hi) CV8_LOAD(vC, first + (n + 2) * stride);
        CV8_PROC(vA, first + n * stride, T0);
        if (n + 1 < n_hi) { if (n + 3 < n_hi) CV8_LOAD(vA, first + (n + 3) * stride); CV8_PROC(vB, first + (n + 1) * stride, T1); }
        if (n + 2 < n_hi) { if (n + 4 < n_hi) CV8_LOAD(vB, first + (n + 4) * stride); CV8_PROC(vC, first + (n + 2) * stride, T2); }
    }
    __syncthreads();
#undef CV8_DECODE
#undef CV8_LOAD
#undef CV8_PROC
}


__device__ __forceinline__ void p_s5tables(const Ctx& F, const int u_first, const int u_stride, const int u_end) {
    LAS float* PW = (LAS float*)(F.lds + LDS_SCR);
    LAS float* BC = PW + 2 * 17 * 64 * 2;
    LAS float* CC = BC + 2 * 64 * 16 * 2;
    LAS float* KL = CC + 2 * 16 * 64 * 2;
    LAS float* CF = KL + 2 * 16 * 16 * 16;
#pragma unroll 1
    for (int unit = u_first; unit < u_end; unit += u_stride) {
        const int it = unit >> 1, half = unit & 1, j2 = it >> 6, g = it & 63;
        __syncthreads();
        if (F.tid < 128) { const int d = F.tid >> 6, n = F.tid & 63, gd = (j2 * 2 + d) * 64 + g, idx = gd * 64 + n;
            const float dt = expf(F.in[18][gd]); const float lr = F.in[16][idx], li = F.in[17][idx];
            const float mag = expf(lr * dt), ang = li * dt; float sn, cs; sincosf(ang, &sn, &cs);
            const float abr = mag * cs, abi = mag * sn, den = lr * lr + li * li, nr = abr - 1.0f, ni = abi;
            CF[(d * 64 + n) * 2] = (nr * lr + ni * li) / den; CF[(d * 64 + n) * 2 + 1] = (ni * lr - nr * li) / den;
            float pr = 1.f, pi = 0.f;
#pragma unroll 1
            for (int k = 0; k < 17; ++k) { PW[((d * 17 + k) * 64 + n) * 2] = pr; PW[((d * 17 + k) * 64 + n) * 2 + 1] = pi; const float tr = pr * abr - pi * abi; pi = pr * abi + pi * abr; pr = tr; }
        }
        __syncthreads();
#pragma unroll 1
        for (int e = F.tid; e < 2048; e += 512) { const int d = e >> 10, gd = (j2 * 2 + d) * 64 + g;
            { const int n = (e >> 4) & 63, p = e & 15; const float cr = CF[(d * 64 + n) * 2], ci = CF[(d * 64 + n) * 2 + 1];
              const float br = F.in[19][((size_t)gd * 64 + n) * 16 + p], bi = F.in[20][((size_t)gd * 64 + n) * 16 + p];
              BC[e * 2] = cr * br - ci * bi; BC[e * 2 + 1] = cr * bi + ci * br; }
            { const int p = (e >> 6) & 15, n = e & 63; CC[e * 2] = F.in[21][(size_t)gd * 1024 + p * 64 + n]; CC[e * 2 + 1] = F.in[22][(size_t)gd * 1024 + p * 64 + n]; } }
        __syncthreads();
        { const int d = F.tid >> 8, k = (F.tid >> 4) & 15, co = F.tid & 15; float acc[16];
#pragma unroll
          for (int ci = 0; ci < 16; ++ci) acc[ci] = 0.f;
#pragma unroll 2
          for (int n = 0; n < 64; ++n) { const float cr = CC[((d * 16 + co) * 64 + n) * 2], cim = CC[((d * 16 + co) * 64 + n) * 2 + 1];
              const float pr = PW[((d * 17 + k) * 64 + n) * 2], pi = PW[((d * 17 + k) * 64 + n) * 2 + 1]; const float zr = cr * pr - cim * pi, zi = cr * pi + cim * pr;
#pragma unroll
              for (int ci = 0; ci < 16; ++ci) acc[ci] += zr * BC[((d * 64 + n) * 16 + ci) * 2] - zi * BC[((d * 64 + n) * 16 + ci) * 2 + 1]; }
#pragma unroll
          for (int ci = 0; ci < 16; ++ci) KL[((d * 16 + k) * 16 + co) * 16 + ci] = acc[ci]; }
        __syncthreads();
        u32x4* t3 = (u32x4*)(F.ws + WS_S5T3 + (size_t)it * 262144);
#pragma unroll 1
        for (int c = half * 8192 + F.tid; c < (half + 1) * 8192; c += 512) {
            const int ln = c & 63, kk = (c >> 6) & 15, tt = (c >> 10) & 1, wv = c >> 11, co = ln & 15, pq = ln >> 4, t = 2 * wv + tt; float v[8];
            if (kk < 8) { const int sq = 2 * kk + (pq >> 1), ci0 = (pq & 1) * 8; const float dsk = F.in[23][j2 * D + g * 16 + co];
#pragma unroll
                for (int e = 0; e < 8; ++e) { const int ci = ci0 + e;
                    v[e] = (sq < t) ? KL[((t - sq) * 16 + co) * 16 + ci] : (sq > t) ? KL[((16 + sq - t) * 16 + co) * 16 + ci] : KL[co * 16 + ci] + KL[(16 * 16 + co) * 16 + ci] + (ci == co ? dsk : 0.f); }
            } else { const int d = kk >= 12 ? 1 : 0, n0 = (((kk - 8) & 3) * 32 + pq * 8) >> 1, pk = d == 0 ? t + 1 : 16 - t;
#pragma unroll
                for (int q = 0; q < 4; ++q) { const int n = n0 + q; const float cr = CC[((d * 16 + co) * 64 + n) * 2], cim = CC[((d * 16 + co) * 64 + n) * 2 + 1];
                    const float pr = PW[((d * 17 + pk) * 64 + n) * 2], pi = PW[((d * 17 + pk) * 64 + n) * 2 + 1]; v[2 * q] = cr * pr - cim * pi; v[2 * q + 1] = -(cr * pi + cim * pr); } }
            u32x4 o; o.x = cvt_pk_bf16(v[0], v[1]); o.y = cvt_pk_bf16(v[2], v[3]); o.z = cvt_pk_bf16(v[4], v[5]); o.w = cvt_pk_bf16(v[6], v[7]); t3[c] = o;
        }
        u32x4* t1 = (u32x4*)(F.ws + WS_S5T1 + (size_t)it * 131072);
#pragma unroll 1
        for (int c = half * 4096 + F.tid; c < (half + 1) * 4096; c += 512) {
            const int ln = c & 63, kk = (c >> 6) & 7, wv = (c >> 9) & 7, d = c >> 12, l16 = ln & 15, pq = ln >> 4;
            const int n = 8 * wv + (l16 >> 1), comp = l16 & 1, sq = 2 * kk + (pq >> 1), ci0 = (pq & 1) * 8, pk = d == 0 ? 15 - sq : sq; float v[8];
            const float pr = PW[((d * 17 + pk) * 64 + n) * 2], pi = PW[((d * 17 + pk) * 64 + n) * 2 + 1];
#pragma unroll
            for (int e = 0; e < 8; ++e) { const float br = BC[((d * 64 + n) * 16 + ci0 + e) * 2], bi = BC[((d * 64 + n) * 16 + ci0 + e) * 2 + 1]; v[e] = comp == 0 ? pr * br - pi * bi : pr * bi + pi * br; }
            u32x4 o; o.x = cvt_pk_bf16(v[0], v[1]); o.y = cvt_pk_bf16(v[2], v[3]); o.z = cvt_pk_bf16(v[4], v[5]); o.w = cvt_pk_bf16(v[6], v[7]); t1[c] = o;
        }
    }
    __syncthreads();
}

__device__ __forceinline__ void p_prologue(const Ctx& F) {
    {
        LAS unsigned* T = (LAS unsigned*)(F.lds + LDS_SCR);
        const int cg = F.tid & 31, kp = F.tid >> 5;
        const int orow = F.tid >> 2, kq = F.tid & 3;
        for (int it = F.blk; it < CV_QKV + CV_WO + CV_GLU; it += F.G) {
            const float* src; bf16_t* dst; int N, K, r0, k0, c0; bool perm = false;
            if (it < CV_QKV) { const int j = it / 192, rem = it % 192; r0 = (rem >> 3) * 128; k0 = (rem & 7) * 128; N = 3072; K = 1024; c0 = r0; perm = r0 < 2048;
                src = F.in[9] + (size_t)j * 1024 * 3072; dst = (bf16_t*)(F.ws + WS_WQKV) + (size_t)j * 3072 * 1024; }
            else if (it < CV_QKV + CV_WO) { const int q = it - CV_QKV, j = q / 64, rem = q % 64; r0 = (rem >> 3) * 128; k0 = (rem & 7) * 128; N = 1024; K = 1024; c0 = r0;
                src = F.in[10] + (size_t)j * 1024 * 1024; dst = (bf16_t*)(F.ws + WS_WO + (size_t)j * 1024 * 1024 * (WO_FP8 ? 1 : 2)); }
            else { const int q = it - CV_QKV - CV_WO, j = q / 128, rem = q % 128; r0 = (rem >> 3) * 128; k0 = (rem & 7) * 128; N = 1024; K = 1024;
                const int tile = r0 >> 8, half = (r0 >> 7) & 1; c0 = tile * 128;
                src = (half ? F.in[25] : F.in[24]) + (size_t)j * 1024 * 1024; dst = (bf16_t*)(F.ws + WS_WGLU + (size_t)j * 2048 * 1024 * (GLU_FP8 ? 1 : 2)); }
            const float wsc = (it < CV_QKV && r0 < 1024) ? QSCALE : 1.0f;
            const float* sp = src + (size_t)(k0 + 2 * kp) * N + c0 + 4 * cg;
            f32x4 va[4], vb[4];
#pragma unroll
            for (int p = 0; p < 4; ++p) { va[p] = *(const f32x4*)(sp + (size_t)(32 * p) * N); vb[p] = *(const f32x4*)(sp + (size_t)(32 * p + 1) * N); }
#pragma unroll
            for (int p = 0; p < 4; ++p)
#pragma unroll
                for (int c = 0; c < 4; ++c) {
                    int lr = 4 * cg + c;
                    if (perm) { const int grp = lr & 64, o = lr & 63, a = o >> 5, half = (o >> 4) & 1, f = o & 15; lr = grp + 2 * (a * 16 + f) + half; }
                    T[lr * 66 + kp + 16 * p] = cvt_pk_bf16(va[p][c] * wsc, vb[p][c] * wsc);
                }
            __syncthreads();
            {
                const LAS u32x2* rp = (const LAS u32x2*)(T + orow * 66 + kq * 16);
                u32x4 o0, o1, o2, o3; u32x2 t0, t1;
                t0 = rp[0]; t1 = rp[1]; o0.x = t0.x; o0.y = t0.y; o0.z = t1.x; o0.w = t1.y;
                t0 = rp[2]; t1 = rp[3]; o1.x = t0.x; o1.y = t0.y; o1.z = t1.x; o1.w = t1.y;
                t0 = rp[4]; t1 = rp[5]; o2.x = t0.x; o2.y = t0.y; o2.z = t1.x; o2.w = t1.y;
                t0 = rp[6]; t1 = rp[7]; o3.x = t0.x; o3.y = t0.y; o3.z = t1.x; o3.w = t1.y;
                if (it < CV_QKV || (!WO_FP8 && it < CV_QKV + CV_WO) || (!GLU_FP8 && it >= CV_QKV + CV_WO)) { u32x4* dp = (u32x4*)(dst + (size_t)(r0 + orow) * K + k0 + kq * 32); dp[0] = o0; dp[1] = o1; dp[2] = o2; dp[3] = o3; }
                else {
#define PK8(w0, w1) pk4_fp8(bf_lo(w0) * W8_SCALE, bf_hi(w0) * W8_SCALE, bf_lo(w1) * W8_SCALE, bf_hi(w1) * W8_SCALE)
                    u32x4 q0, q1; q0.x = PK8(o0.x, o0.y); q0.y = PK8(o0.z, o0.w); q0.z = PK8(o1.x, o1.y); q0.w = PK8(o1.z, o1.w);
                    q1.x = PK8(o2.x, o2.y); q1.y = PK8(o2.z, o2.w); q1.z = PK8(o3.x, o3.y); q1.w = PK8(o3.z, o3.w);
#undef PK8
                    u32x4* dp = (u32x4*)((unsigned char*)dst + (size_t)(r0 + orow) * K + k0 + kq * 32); dp[0] = q0; dp[1] = q1; }
            }
            __syncthreads();
        }
    }
    if (!F.split) p_convert_fp8(F, F.blk, F.G, 0, (CV_GU + CV_D + F.G - 1 - F.blk) / F.G);
    {
        LAS float* sc = (LAS float*)(F.lds + LDS_SCR);
        LAS float* red = sc + 17 * 1024;
        if (F.blk < 192) {
            for (int idx = F.tid; idx < 17 * 1024; idx += 512) { const int s = idx >> 10, k = idx & 1023; const float v = s < 16 ? F.in[1][s * 1024 + k] : F.in[3][k]; sc[idx] = siluf_(v); }
            __syncthreads();
        }
        for (int it = F.blk; it < 192; it += F.G) {
            const int i = it / 48, n0 = (it % 48) * 128, nl = F.tid & 127, kq = F.tid >> 7;
            float acc[17];
#pragma unroll
            for (int s = 0; s < 17; ++s) acc[s] = 0.f;
            const float* wp = F.in[4] + ((size_t)i * 1024 + kq * 256) * NMOD + n0 + nl;
#pragma unroll 2
            for (int k = 0; k < 256; k += 4) {
                const float w0 = wp[(size_t)k * NMOD], w1 = wp[(size_t)(k + 1) * NMOD], w2 = wp[(size_t)(k + 2) * NMOD], w3 = wp[(size_t)(k + 3) * NMOD];
#pragma unroll
                for (int s = 0; s < 17; ++s) { const f32x4 c4 = *(const LAS f32x4*)(sc + s * 1024 + kq * 256 + k);
                    acc[s] += c4[0] * w0 + c4[1] * w1 + c4[2] * w2 + c4[3] * w3; } }
#pragma unroll
            for (int s = 0; s < 17; ++s) red[(kq * 17 + s) * 128 + nl] = acc[s];
            __syncthreads();
            for (int idx = F.tid; idx < 17 * 128; idx += 512) { const int s = idx >> 7, n = idx & 127;
                const float v = red[(0 * 17 + s) * 128 + n] + red[(1 * 17 + s) * 128 + n] + red[(2 * 17 + s) * 128 + n] + red[(3 * 17 + s) * 128 + n] + F.in[5][i * NMOD + n0 + n];
                F.mod()[((size_t)i * 17 + s) * NMOD + n0 + n] = v; }
            __syncthreads();
        }
    }
    for (int idx = F.blk * 512 + F.tid; idx < 2048 * 32; idx += F.G * 512) {
        const int t = idx >> 5, fp = idx & 31, a = fp >> 4, f = fp & 15; const float pos = (float)(a ? (t & 63) : (t >> 6));
        const float inv = powf(10000.0f, -(float)f / 16.0f); const float ang = pos * inv; float s, c; sincosf(ang, &s, &c);
        float* rt = (float*)(F.ws + WS_ROPE); rt[idx * 2] = c; rt[idx * 2 + 1] = s;
    }
    for (int idx = F.blk * 512 + F.tid; idx < 2 * 2 * 64 * 64; idx += F.G * 512) {
        const int n = idx & 63, gd = idx >> 6;
        const float dt = expf(F.in[18][gd]); const float lr = F.in[16][idx], li = F.in[17][idx];
        const float mag = expf(lr * dt), ang = li * dt; float sn, cs; sincosf(ang, &sn, &cs);
        const float abr = mag * cs, abi = mag * sn;
        float* ab = (float*)(F.ws + WS_S5AB); ab[idx * 2] = abr; ab[idx * 2 + 1] = abi;
    }
    if (F.blk == 0 && F.tid < 2) {
        const int j = F.tid; float s1 = 0.f, s2 = 0.f;
        for (int k = 0; k < 64; ++k) { s1 += F.in[11][j * 64 + k] * F.in[12][j * 64 + k]; s2 += F.in[13][j * 64 + k] * F.in[14][j * 64 + k]; }
        const float lam_init = 0.8f - 0.6f * expf(-0.3f * (float)(2 * j));
        float* lv = (float*)(F.ws + WS_LAM); lv[j * 2] = expf(s1) - expf(s2) + lam_init; lv[j * 2 + 1] = 1.0f - lam_init;
    }
    if (!(F.G == 256)) p_s5tables(F, F.blk, F.G, 256);
}

__device__ __forceinline__ void p_rows_R0(const Ctx& F) {
    const int rpb = (NTOK + F.G - 1) / F.G;
    const int r_hi = ((F.blk + 1) * rpb < NTOK) ? (F.blk + 1) * rpb : NTOK, r_lo = F.blk * rpb + F.wave;
#define R0_LOAD(PX, rw) { const float* src = ((rw) < NLAT) ? F.in[0] + (size_t)(rw) * D : F.in[2] + (size_t)((rw) - NLAT) * D; \
        _Pragma("unroll") for (int i = 0; i < 4; ++i) PX[i] = *(const f32x4*)(src + i * 256 + lane * 4); }
    f32x4 xa[4], xb[4];
#pragma unroll
    for (int i = 0; i < 4; ++i) { xa[i] = (f32x4){0.f, 0.f, 0.f, 0.f}; xb[i] = xa[i]; }
    { const int lane = F.lane;
      if (r_lo < r_hi) R0_LOAD(xa, r_lo)
      if (r_lo + 8 < r_hi) R0_LOAD(xb, r_lo + 8) }
    int s_cur = -1; f32x4 Am[4], Bm[4];
#pragma unroll
    for (int i = 0; i < 4; ++i) { Am[i] = (f32x4){0.f, 0.f, 0.f, 0.f}; Bm[i] = Am[i]; }
#pragma unroll 1
    for (int row = r_lo; row < r_hi; row += 16) {
        int lane; asm volatile("v_mbcnt_lo_u32_b32 %0, -1, 0\n\tv_mbcnt_hi_u32_b32 %0, -1, %0" : "=v"(lane));
        const bool hasB = row + 8 < r_hi; const int s = (row < NLAT) ? (row >> 11) : 16;
        f32x4 va[4], vb[4];
#pragma unroll
        for (int i = 0; i < 4; ++i) { va[i] = xa[i]; vb[i] = xb[i]; }
        if (s != s_cur) { s_cur = s; const float* mp = F.mod() + (size_t)s * NMOD;
#pragma unroll
            for (int i = 0; i < 4; ++i) { const int c = i * 256 + lane * 4; const f32x4 g = *(const f32x4*)(F.in[6] + c);
                Bm[i] = *(const f32x4*)(mp + c); Am[i] = g * (*(const f32x4*)(mp + D + c) + 1.0f); }
#pragma unroll
            for (int i = 0; i < 4; ++i) asm volatile("" : "+v"(Am[i]), "+v"(Bm[i]));
        }
        if (row + 16 < r_hi) R0_LOAD(xa, row + 16)
        if (row + 24 < r_hi) R0_LOAD(xb, row + 24)
#define R0_FINISH(XV, rw) { float ss = 0.f; \
        _Pragma("unroll") for (int i = 0; i < 4; ++i) ss += XV[i][0] * XV[i][0] + XV[i][1] * XV[i][1] + XV[i][2] * XV[i][2] + XV[i][3] * XV[i][3]; \
        ss = wave_sum(ss); const float rstd = rsqrtf(ss * (1.0f / 1024.0f) + EPS); \
        _Pragma("unroll") for (int i = 0; i < 4; ++i) { const int c = i * 256 + lane * 4; const f32x4 h = XV[i] * rstd * Am[i] + Bm[i]; *(u32x2*)(F.H() + (size_t)(rw) * D + c) = bf4_pack(h); } }
        R0_FINISH(va, row)
        if (hasB) R0_FINISH(vb, row + 8)
#undef R0_FINISH
    }
#undef R0_LOAD
}

__device__ __forceinline__ void p_rows_R(const Ctx& F, const int layer) {
    if (layer == 0) { p_rows_R0(F); return; }
    const int nrows = (layer == 4) ? NLAT : NTOK;
    const int rpb = (nrows + F.G - 1) / F.G;
    const int r_hi = ((F.blk + 1) * rpb < nrows) ? (F.blk + 1) * rpb : nrows, r_lo = F.blk * rpb + F.wave;
#define R_LOAD(PXB, PSEL, PAFF, rw) { const bf16_t* src = F.XB() + (size_t)(rw) * D; _Pragma("unroll") for (int i = 0; i < 4; ++i) PXB[i] = *(const u32x2*)(src + i * 256 + lane * 4); \
        if (lane < 16) { PSEL = F.SEL()[(size_t)(rw) * 16 + lane]; PAFF = F.AFF()[(size_t)(rw) * 16 + lane]; } }
    u32x2 xbA[4], xbB[4]; int selA = -1, selB = -1; float affA = 0.f, affB = 0.f;
#pragma unroll
    for (int i = 0; i < 4; ++i) { xbA[i] = (u32x2){0u, 0u}; xbB[i] = xbA[i]; }
    { const int lane = F.lane;
      if (r_lo < r_hi) R_LOAD(xbA, selA, affA, r_lo)
      if (r_lo + 8 < r_hi) R_LOAD(xbB, selB, affB, r_lo + 8) }
    int s_cur = -1; f32x4 Am[4], Bm[4], g2[4];
#pragma unroll
    for (int i = 0; i < 4; ++i) { Am[i] = (f32x4){0.f, 0.f, 0.f, 0.f}; Bm[i] = Am[i]; g2[i] = Am[i]; }
#pragma unroll 1
    for (int row = r_lo; row < r_hi; row += 16) {
        int lane; asm volatile("v_mbcnt_lo_u32_b32 %0, -1, 0\n\tv_mbcnt_hi_u32_b32 %0, -1, %0" : "=v"(lane));
        const bool hasB = row + 8 < r_hi;
        const bool lat = row < NLAT; const int s = lat ? (row >> 11) : 16;
        f32x4 xvA[4], xvB[4];
#pragma unroll
        for (int i = 0; i < 4; ++i) { xvA[i] = bf4_unpack(xbA[i]); xvB[i] = bf4_unpack(xbB[i]); }
        const int selvA = selA, selvB = selB; const float affvA = affA, affvB = affB;
        if (s != s_cur) { s_cur = s;
#pragma unroll
            for (int i = 0; i < 4; ++i) { const int c = i * 256 + lane * 4;
                if (layer == 4) { Am[i] = *(const f32x4*)(F.in[8] + c); }
                else { const float* mp = F.mod() + ((size_t)layer * 17 + s) * NMOD; const f32x4 g = *(const f32x4*)(F.in[6] + layer * D + c);
                    Bm[i] = *(const f32x4*)(mp + c); Am[i] = g * (*(const f32x4*)(mp + D + c) + 1.0f); }
                g2[i] = *(const f32x4*)(F.mod() + ((size_t)(layer - 1) * 17 + s) * NMOD + 5 * D + c); }
#pragma unroll
            for (int i = 0; i < 4; ++i) asm volatile("" : "+v"(Am[i]), "+v"(Bm[i]), "+v"(g2[i]));
        }
        if (row + 16 < r_hi) R_LOAD(xbA, selA, affA, row + 16)
        if (row + 24 < r_hi) R_LOAD(xbB, selB, affB, row + 24)
        {
            const int pbase = lat ? ((row >> 11) * 256) : (4096 + ((row - NLAT) >> 8) * 32);
            unsigned mA = (unsigned)__ballot(lane < 16 && selvA >= 0) & 0xFFFFu, mB = hasB ? ((unsigned)__ballot(lane < 16 && selvB >= 0) & 0xFFFFu) : 0u;
            int yA[4][4], yB[4][4]; float wA[4], wB[4];
#define R_ISSUE(PY, PW, PM, SELV, AFFV) _Pragma("unroll") for (int k = 0; k < 4; ++k) { \
                if (PM) { const int e = __builtin_ctz(PM); PM &= PM - 1u; const int slot = __builtin_amdgcn_readlane(SELV, e); \
                    PW[k] = __uint_as_float(__builtin_amdgcn_readlane(__float_as_uint(AFFV), e)) * Y8_INV; \
                    const unsigned char* yp = (const unsigned char*)F.Y() + ((size_t)e * EROWS + pbase + slot) * D + lane * 4; \
                    _Pragma("unroll") for (int i = 0; i < 4; ++i) PY[k][i] = *(const int*)(yp + i * 256); } \
                else { PW[k] = 0.f; _Pragma("unroll") for (int i = 0; i < 4; ++i) PY[k][i] = 0; } }
#define R_ACC(XV, YV, WV) _Pragma("unroll") for (int i = 0; i < 4; ++i) { const f32x2 ylo = __builtin_amdgcn_cvt_pk_f32_fp8(YV[i], false), yhi = __builtin_amdgcn_cvt_pk_f32_fp8(YV[i], true); \
                XV[i][0] += g2[i][0] * WV * ylo[0]; XV[i][1] += g2[i][1] * WV * ylo[1]; XV[i][2] += g2[i][2] * WV * yhi[0]; XV[i][3] += g2[i][3] * WV * yhi[1]; }
            R_ISSUE(yA, wA, mA, selvA, affvA)
            R_ISSUE(yB, wB, mB, selvB, affvB)
#pragma unroll
            for (int k = 0; k < 4; ++k) { R_ACC(xvA, yA[k], wA[k]) R_ACC(xvB, yB[k], wB[k]) }
            while (mA) { int yt[4]; const int e = __builtin_ctz(mA); mA &= mA - 1u; const int slot = __builtin_amdgcn_readlane(selvA, e);
                const float wt = __uint_as_float(__builtin_amdgcn_readlane(__float_as_uint(affvA), e)) * Y8_INV;
                const unsigned char* yp = (const unsigned char*)F.Y() + ((size_t)e * EROWS + pbase + slot) * D + lane * 4;
#pragma unroll
                for (int i = 0; i < 4; ++i) yt[i] = *(const int*)(yp + i * 256);
                R_ACC(xvA, yt, wt) }
            while (mB) { int yt[4]; const int e = __builtin_ctz(mB); mB &= mB - 1u; const int slot = __builtin_amdgcn_readlane(selvB, e);
                const float wt = __uint_as_float(__builtin_amdgcn_readlane(__float_as_uint(affvB), e)) * Y8_INV;
                const unsigned char* yp = (const unsigned char*)F.Y() + ((size_t)e * EROWS + pbase + slot) * D + lane * 4;
#pragma unroll
                for (int i = 0; i < 4; ++i) yt[i] = *(const int*)(yp + i * 256);
                R_ACC(xvB, yt, wt) }
#undef R_ISSUE
#undef R_ACC
        }
#define R_FINISH(XV, rw) { \
        if (layer < 4) { _Pragma("unroll") for (int i = 0; i < 4; ++i) *(u32x2*)(F.XB() + (size_t)(rw) * D + i * 256 + lane * 4) = bf4_pack(XV[i]); } \
        float ss = 0.f; \
        _Pragma("unroll") for (int i = 0; i < 4; ++i) ss += XV[i][0] * XV[i][0] + XV[i][1] * XV[i][1] + XV[i][2] * XV[i][2] + XV[i][3] * XV[i][3]; \
        ss = wave_sum(ss); const float rstd = rsqrtf(ss * (1.0f / 1024.0f) + EPS); \
        if (layer == 4) { _Pragma("unroll") for (int i = 0; i < 4; ++i) *(f32x4*)(F.out + (size_t)(rw) * D + i * 256 + lane * 4) = XV[i] * rstd * Am[i]; } \
        else { _Pragma("unroll") for (int i = 0; i < 4; ++i) { const int c = i * 256 + lane * 4; const f32x4 h = XV[i] * rstd * Am[i] + Bm[i]; \
                *(u32x2*)(F.H() + (size_t)(rw) * D + c) = bf4_pack(h); } } }
        R_FINISH(xvA, row)
        if (hasB) R_FINISH(xvB, row + 8)
#undef R_FINISH
    }
#undef R_LOAD
}

__device__ __forceinline__ void p_rows_M1(const Ctx& F, const int layer) {
    const int nrows = (layer < 3) ? NTOK : NLAT;
    LAS char* WT = (LAS char*)(F.lds + LDS_SCR);
    LAS float* MV = (LAS float*)(WT + 2 * 16 * 2064);
    const int rpw = (nrows + F.G * 8 - 1) / (F.G * 8), rpb = rpw * 8, RP = (rpw + 1) >> 1;
    const int blk_lo = F.blk * rpb; const int blk_hi = (blk_lo + rpb < nrows ? blk_lo + rpb : nrows) - 1;
#define M1_S(r) (((r) < NLAT) ? ((r) >> 11) : 16)
    const int s0 = M1_S(blk_lo < nrows ? blk_lo : nrows - 1), s1 = M1_S(blk_hi > 0 ? blk_hi : 0);
#pragma unroll 1
    for (int idx = F.tid; idx < 1024 * 4; idx += 512) { const int k = idx >> 2, e4 = idx & 3;
        const f32x4 v = *(const f32x4*)(F.in[26] + ((size_t)layer * 1024 + k) * 16 + e4 * 4);
#pragma unroll
        for (int j = 0; j < 4; ++j) { const unsigned hi = cvt_pk_bf16(v[j], v[j]) & 0xffffu; const float lo = v[j] - __uint_as_float(hi << 16);
            *(LAS unsigned short*)(WT + (e4 * 4 + j) * 2064 + k * 2) = (unsigned short)hi; *(LAS unsigned short*)(WT + (16 + e4 * 4 + j) * 2064 + k * 2) = (unsigned short)cvt_pk_bf16(lo, lo); } }
#pragma unroll 1
    for (int idx = F.tid; idx < 2048; idx += 512) { const int sel = idx >> 10, c = idx & 1023, sb = sel ? s1 : s0;
        const float* mp = F.mod() + ((size_t)layer * 17 + sb) * NMOD + 3 * D; const float g = F.in[7][layer * D + c];
        MV[sel * 2048 + c] = g * (mp[D + c] + 1.0f); MV[sel * 2048 + 1024 + c] = mp[c]; }
    __syncthreads();
    const int lane = F.lane, l16 = lane & 15, pq = lane >> 4;
    const float bias = F.in[27][layer * 16 + l16];
#pragma unroll 1
    for (int p = 0; p < 2; ++p) {
        const int rbase = blk_lo + F.wave * rpw + p * RP, rcnt = (p == 0) ? RP : rpw - RP;
        int lr = l16 < rcnt ? l16 : rcnt - 1; if (lr < 0) lr = 0; int row = rbase + lr; if (row >= nrows) row = nrows - 1;
        const bool valid = l16 < rcnt && rbase + l16 < nrows;
        const int sel = (M1_S(row) != s0) ? 1 : 0;
        const bf16_t* xp = F.XB() + (size_t)row * D + pq * 8;
        u32x4 xr[32];
#pragma unroll
        for (int kk = 0; kk < 32; ++kk) xr[kk] = *(const u32x4*)(xp + kk * 32);
        float ss = 0.f;
#pragma unroll
        for (int kk = 0; kk < 32; ++kk) { const u32x4 t = xr[kk];
            const float a0 = bf_lo(t.x), a1 = bf_hi(t.x), a2 = bf_lo(t.y), a3 = bf_hi(t.y), a4 = bf_lo(t.z), a5 = bf_hi(t.z), a6 = bf_lo(t.w), a7 = bf_hi(t.w);
            ss += a0 * a0 + a1 * a1 + a2 * a2 + a3 * a3 + a4 * a4 + a5 * a5 + a6 * a6 + a7 * a7; }
        ss += __shfl_xor(ss, 16); ss += __shfl_xor(ss, 32);
        const float rstd = rsqrtf(ss * (1.0f / 1024.0f) + EPS);
#pragma unroll
        for (int kk = 0; kk < 32; ++kk) asm volatile("" : "+v"(xr[kk]));
        f32x4 acc = {0.f, 0.f, 0.f, 0.f};
        const LAS float* mv = MV + sel * 2048 + pq * 8; const LAS char* wt = WT + l16 * 2064 + pq * 16;
        unsigned char* hq = F.H2Q() + (size_t)row * D + pq * 8;
#pragma unroll
        for (int kk = 0; kk < 32; ++kk) { const u32x4 t = xr[kk];
            const f32x4 am0 = *(const LAS f32x4*)(mv + kk * 32), am1 = *(const LAS f32x4*)(mv + kk * 32 + 4), bm0 = *(const LAS f32x4*)(mv + 1024 + kk * 32), bm1 = *(const LAS f32x4*)(mv + 1024 + kk * 32 + 4);
            f32x4 h0, h1;
            h0[0] = bf_lo(t.x) * rstd * am0[0] + bm0[0]; h0[1] = bf_hi(t.x) * rstd * am0[1] + bm0[1]; h0[2] = bf_lo(t.y) * rstd * am0[2] + bm0[2]; h0[3] = bf_hi(t.y) * rstd * am0[3] + bm0[3];
            h1[0] = bf_lo(t.z) * rstd * am1[0] + bm1[0]; h1[1] = bf_hi(t.z) * rstd * am1[1] + bm1[1]; h1[2] = bf_lo(t.w) * rstd * am1[2] + bm1[2]; h1[3] = bf_hi(t.w) * rstd * am1[3] + bm1[3];
            if (valid) { u32x2 q; q.x = pk4_fp8(h0[0] * H8_SCALE, h0[1] * H8_SCALE, h0[2] * H8_SCALE, h0[3] * H8_SCALE); q.y = pk4_fp8(h1[0] * H8_SCALE, h1[1] * H8_SCALE, h1[2] * H8_SCALE, h1[3] * H8_SCALE);
                *(u32x2*)(hq + kk * 32) = q; }
            u32x4 ah, al;
            ah.x = cvt_pk_bf16(h0[0], h0[1]); ah.y = cvt_pk_bf16(h0[2], h0[3]); ah.z = cvt_pk_bf16(h1[0], h1[1]); ah.w = cvt_pk_bf16(h1[2], h1[3]);
            al.x = cvt_pk_bf16(h0[0] - bf_lo(ah.x), h0[1] - bf_hi(ah.x)); al.y = cvt_pk_bf16(h0[2] - bf_lo(ah.y), h0[3] - bf_hi(ah.y));
            al.z = cvt_pk_bf16(h1[0] - bf_lo(ah.z), h1[1] - bf_hi(ah.z)); al.w = cvt_pk_bf16(h1[2] - bf_lo(ah.w), h1[3] - bf_hi(ah.w));
            const bf16x8 bh = *(const LAS bf16x8*)(wt + kk * 64), bl = *(const LAS bf16x8*)(wt + 16 * 2064 + kk * 64);
            const bf16x8 Ah = __builtin_bit_cast(bf16x8, ah), Al = __builtin_bit_cast(bf16x8, al);
            acc = __builtin_amdgcn_mfma_f32_16x16x32_bf16(Ah, bh, acc, 0, 0, 0);
            acc = __builtin_amdgcn_mfma_f32_16x16x32_bf16(Al, bh, acc, 0, 0, 0);
            acc = __builtin_amdgcn_mfma_f32_16x16x32_bf16(Ah, bl, acc, 0, 0, 0);
            if ((kk & 1) == 1) { asm volatile("" ::: "memory"); __builtin_amdgcn_sched_barrier(0); }
        }
#pragma unroll
        for (int i = 0; i < 4; ++i) {
            const float lgt = acc[i] + bias; float mx = lgt;
#pragma unroll
            for (int o = 1; o <= 8; o <<= 1) mx = fmaxf(mx, __shfl_xor(mx, o));
            const float ex = expf(lgt - mx); float sum = ex;
#pragma unroll
            for (int o = 1; o <= 8; o <<= 1) sum += __shfl_xor(sum, o);
            const int tr = pq * 4 + i;
            if (tr < rcnt && rbase + tr < nrows) F.AFF()[(size_t)(rbase + tr) * 16 + l16] = ex / sum;
        }
    }
#undef M1_S
}

__device__ __forceinline__ void p_topk(const Ctx& F, const int layer) {
    LAS unsigned* hist = (LAS unsigned*)(F.lds + LDS_SCR);
    LAS unsigned* ctl = hist + 512;
    LAS unsigned* wsum = hist + 520;
    const int lane = F.lane, wave = F.wave;
    const bool has_c = layer < 3;
    for (int q = F.blk; q < 256; q += F.G) {
        const int b = q >> 4, e = q & 15;
        const int base = b * 2048, basec = NLAT + b * 256;
        const bool vc = has_c && F.tid < 256;
        unsigned key[4];
#pragma unroll
        for (int j = 0; j < 4; ++j) key[j] = __float_as_uint(F.AFF()[(size_t)(base + 4 * F.tid + j) * 16 + e]);
        const unsigned keyc = vc ? __float_as_uint(F.AFF()[(size_t)(basec + F.tid) * 16 + e]) : 0u;
        unsigned prefix = 0u, rem = 256u, prefc = 0u, remc = 32u;
#pragma unroll
        for (int pass = 0; pass < 4; ++pass) {
            const int shift = 24 - 8 * pass;
            hist[F.tid] = 0u;
            __syncthreads();
#pragma unroll
            for (int j = 0; j < 4; ++j) if (pass == 0 || (key[j] >> (shift + 8)) == prefix) (void)__hip_atomic_fetch_add(&hist[(key[j] >> shift) & 255u], 1u, __ATOMIC_RELAXED, __HIP_MEMORY_SCOPE_WORKGROUP);
            if (vc && (pass == 0 || (keyc >> (shift + 8)) == prefc)) (void)__hip_atomic_fetch_add(&hist[256u + ((keyc >> shift) & 255u)], 1u, __ATOMIC_RELAXED, __HIP_MEMORY_SCOPE_WORKGROUP);
            __syncthreads();
            if (wave == 0 || (wave == 1 && has_c)) {
                const LAS unsigned* hh = hist + 256 * wave; const unsigned pf = wave ? prefc : prefix, rm = wave ? remc : rem;
                const unsigned c0 = hh[4 * lane], c1 = hh[4 * lane + 1], c2 = hh[4 * lane + 2], c3 = hh[4 * lane + 3];
                const unsigned sl = c0 + c1 + c2 + c3; unsigned v = sl;
#pragma unroll
                for (int o = 1; o < 64; o <<= 1) { const unsigned t = __shfl_down(v, o); if (lane + o < 64) v += t; }
                const unsigned ab3 = v - sl, ab2 = ab3 + c3, ab1 = ab2 + c2, ab0 = ab1 + c1;
                if (ab3 < rm && rm <= ab3 + c3) { ctl[2 * wave] = (pf << 8) | (unsigned)(4 * lane + 3); ctl[2 * wave + 1] = rm - ab3; }
                if (ab2 < rm && rm <= ab2 + c2) { ctl[2 * wave] = (pf << 8) | (unsigned)(4 * lane + 2); ctl[2 * wave + 1] = rm - ab2; }
                if (ab1 < rm && rm <= ab1 + c1) { ctl[2 * wave] = (pf << 8) | (unsigned)(4 * lane + 1); ctl[2 * wave + 1] = rm - ab1; }
                if (ab0 < rm && rm <= ab0 + c0) { ctl[2 * wave] = (pf << 8) | (unsigned)(4 * lane + 0); ctl[2 * wave + 1] = rm - ab0; }
            }
            __syncthreads();
            prefix = ctl[0]; rem = ctl[1]; prefc = ctl[2]; remc = ctl[3];
        }
        unsigned eqc = 0u;
#pragma unroll
        for (int j = 0; j < 4; ++j) eqc += (key[j] == prefix) ? 1u : 0u;
        const unsigned eqcc = (vc && keyc == prefc) ? 1u : 0u;
        unsigned v = eqc, vv = eqcc;
#pragma unroll
        for (int o = 1; o < 64; o <<= 1) { const unsigned t = __shfl_up(v, o), tt = __shfl_up(vv, o); if (lane >= o) { v += t; vv += tt; } }
        if (lane == 63) { wsum[wave] = v; wsum[8 + wave] = vv; }
        __syncthreads();
        unsigned eqb = v - eqc, eqbc = vv - eqcc;
#pragma unroll
        for (int w = 0; w < 8; ++w) { eqb += (w < wave) ? wsum[w] : 0u; eqbc += (w < wave) ? wsum[8 + w] : 0u; }
        bool sel[4]; unsigned selc = 0u;
#pragma unroll
        for (int j = 0; j < 4; ++j) { const bool eq = key[j] == prefix; sel[j] = key[j] > prefix || (eq && eqb < rem); eqb += eq ? 1u : 0u; selc += sel[j] ? 1u : 0u; }
        const bool selx = vc && (keyc > prefc || (keyc == prefc && eqbc < remc)); const unsigned selcc = selx ? 1u : 0u;
        __syncthreads();
        v = selc; vv = selcc;
#pragma unroll
        for (int o = 1; o < 64; o <<= 1) { const unsigned t = __shfl_up(v, o), tt = __shfl_up(vv, o); if (lane >= o) { v += t; vv += tt; } }
        if (lane == 63) { wsum[wave] = v; wsum[8 + wave] = vv; }
        __syncthreads();
        unsigned slot = v - selc, slotc = vv - selcc;
#pragma unroll
        for (int w = 0; w < 8; ++w) { slot += (w < wave) ? wsum[w] : 0u; slotc += (w < wave) ? wsum[8 + w] : 0u; }
#pragma unroll
        for (int j = 0; j < 4; ++j) { const int row = base + 4 * F.tid + j;
            if (sel[j]) { F.MIDX()[e * EROWS + b * 256 + (int)slot] = row; F.SEL()[(size_t)row * 16 + e] = (int)slot; ++slot; }
            else F.SEL()[(size_t)row * 16 + e] = -1; }
        if (vc) { const int row = basec + F.tid;
            if (selx) { F.MIDX()[e * EROWS + 4096 + b * 32 + (int)slotc] = row; F.SEL()[(size_t)row * 16 + e] = (int)slotc; }
            else F.SEL()[(size_t)row * 16 + e] = -1; }
        __syncthreads();
    }
}

namespace pg8 {
constexpr int BM = 256, BK = 64, HALF = 128, HTB = HALF * BK * 2, STAGE_BYTES = 8 * HTB;
__device__ __forceinline__ int lds_byte(int r, int c) { const int st = (r >> 4) * 2 + (c >> 5), rr = r & 15, cc = c & 31, ob = rr * 64 + cc * 2; return st * 1024 + (ob ^ (((ob >> 9) & 1) << 5)); }
__device__ __forceinline__ void stage_rc(int b, int& R, int& C) { const int st = b / 1024, sb = b % 1024, swz = sb ^ (((sb >> 9) & 1) << 5); R = (st >> 1) * 16 + swz / 64; C = (st & 1) * 32 + (swz % 64) / 2; }
__device__ __forceinline__ int perm32(int rho) { const int n = rho >> 4, i = rho & 15; return 8 * (i >> 2) + 4 * n + (i & 3); }
struct Unit { int pm, pn, e; };

template <class P>
__device__ __forceinline__ void gemm_phase(LAS unsigned char* lds, const P& pr, const int tid) {
    constexpr int K = P::K; constexpr int nt = K / BK;
    const int wid = __builtin_amdgcn_readfirstlane(tid >> 6), wr = wid >> 2, wc = wid & 3, lane = tid & 63, fr = lane & 15, fq = lane >> 4;
    unsigned voffB[2];
#pragma unroll
    for (int i = 0; i < 2; ++i) { int R, C; stage_rc(tid * 16 + i * 8192, R, C); const int Rb = P::PERM ? ((R & ~31) + perm32(R & 31)) : R; voffB[i] = (unsigned)(Rb * K + C) * 2u; }
    const size_t kstep = (size_t)(BK * 2);
    const size_t hstep = (size_t)HALF * K * 2;
    const unsigned ldsw = (unsigned)wid * 1024u;
    const int aoff = lds_byte(wr * 64 + fr, fq * 8), boff = lds_byte(wc * 32 + fr, fq * 8);
#define PG8_SA(b, h) (((b) * 2 + (h)) * HTB)
#define PG8_SB(b, h) ((4 + (b) * 2 + (h)) * HTB)
#define PG8_STAGE(bufoff, gbase, voff) do { _Pragma("unroll") for (int _i = 0; _i < 2; ++_i) \
        __builtin_amdgcn_global_load_lds((const unsigned*)((const char*)(gbase) + (voff)[_i]), (LAS unsigned*)(lds + (bufoff) + ldsw + _i * 8192), 16, 0, 0); } while (0)
#define PG8_LDA(dst, b, h) do { _Pragma("unroll") for (int m = 0; m < 4; ++m) _Pragma("unroll") for (int k = 0; k < 2; ++k) dst[m][k] = *(const LAS bf16x8*)(lds + PG8_SA(b, h) + aoff + m * 2048 + k * 1024); } while (0)
#define PG8_LDB(dst, b, h) do { _Pragma("unroll") for (int n = 0; n < 2; ++n) _Pragma("unroll") for (int k = 0; k < 2; ++k) dst[n][k] = *(const LAS bf16x8*)(lds + PG8_SB(b, h) + boff + n * 2048 + k * 1024); } while (0)
#define PG8_MMA(ai, bj, At, Bt) do { __builtin_amdgcn_s_setprio(1); _Pragma("unroll") for (int m = 0; m < 4; ++m) _Pragma("unroll") for (int n = 0; n < 2; ++n) _Pragma("unroll") for (int k = 0; k < 2; ++k) \
        acc[ai][bj][m][n] = __builtin_amdgcn_mfma_f32_16x16x32_bf16(Bt[n][k], At[m][k], acc[ai][bj][m][n], 0, 0, 0); __builtin_amdgcn_s_setprio(0); } while (0)
#define PG8_WAIT_V(n) asm volatile("s_waitcnt vmcnt(" #n ")" ::: "memory")
#define PG8_WAIT_L(n) asm volatile("s_waitcnt lgkmcnt(" #n ")" ::: "memory")
#define PG8_BAR __builtin_amdgcn_s_barrier()
#define PG8_SCHED __builtin_amdgcn_sched_barrier(0)
    Unit cur, nxt; int ui = 0;
    if (!pr.next(0, cur)) return;
    f32x4 acc[2][2][4][2];
#pragma unroll
    for (int a = 0; a < 2; ++a)
#pragma unroll
        for (int b = 0; b < 2; ++b)
#pragma unroll
            for (int m = 0; m < 4; ++m)
#pragma unroll
                for (int n = 0; n < 2; ++n) acc[a][b][m][n] = (f32x4){0.f, 0.f, 0.f, 0.f};
    bf16x8 At[4][2], B0[2][2], B1[2][2];
    unsigned vA0[2], vA1[2];
#pragma unroll
    for (int i = 0; i < 2; ++i) { int R, C; stage_rc(tid * 16 + i * 8192, R, C); vA0[i] = (unsigned)(pr.a_row(cur, R) * K + C) * 2u; vA1[i] = (unsigned)(pr.a_row(cur, HALF + R) * K + C) * 2u; }
    const char* Ab = (const char*)pr.A;
    const char* cB = (const char*)pr.b_tile(cur);
    PG8_STAGE(PG8_SB(0, 0), cB, voffB); PG8_STAGE(PG8_SB(0, 1), cB + hstep, voffB); PG8_STAGE(PG8_SA(0, 0), Ab, vA0); PG8_STAGE(PG8_SA(0, 1), Ab, vA1);
    if (wr == 1) PG8_BAR;
    PG8_WAIT_V(2); PG8_BAR;
    PG8_STAGE(PG8_SB(1, 0), cB + kstep, voffB); PG8_STAGE(PG8_SA(1, 0), Ab + kstep, vA0); PG8_STAGE(PG8_SB(1, 1), cB + hstep + kstep, voffB);
    PG8_WAIT_V(6); PG8_BAR;
    for (;;) {
        const bool has_next = pr.next(ui + 1, nxt);
        const char* nB = has_next ? (const char*)pr.b_tile(nxt) : cB;
#pragma unroll 1
        for (int t = 0; t < nt; t += 2) {
            const bool last = (t == nt - 2);
            const char* a1 = Ab + (size_t)(t + 1) * kstep;
            const char* a2 = last ? Ab : Ab + (size_t)(t + 2) * kstep; const char* b2 = last ? nB : cB + (size_t)(t + 2) * kstep;
            const char* a3 = a2 + kstep; const char* b3 = b2 + kstep;
            PG8_LDB(B0, 0, 0); PG8_LDB(B1, 0, 1); PG8_SCHED; PG8_LDA(At, 0, 0); PG8_STAGE(PG8_SA(1, 1), a1, vA1);
            if (last && has_next) {
#pragma unroll
                for (int i = 0; i < 2; ++i) { int R, C; stage_rc(tid * 16 + i * 8192, R, C);
                    vA0[i] = (unsigned)(pr.a_row(nxt, R) * K + C) * 2u; vA1[i] = (unsigned)(pr.a_row(nxt, HALF + R) * K + C) * 2u; }
            }
            PG8_WAIT_V(8); PG8_WAIT_L(0); PG8_BAR; PG8_MMA(0, 0, At, B0); PG8_MMA(0, 1, At, B1); PG8_BAR; PG8_SCHED;
            PG8_LDA(At, 0, 1); PG8_STAGE(PG8_SB(0, 0), b2, voffB); PG8_STAGE(PG8_SB(0, 1), b2 + hstep, voffB); PG8_STAGE(PG8_SA(0, 0), a2, vA0);
            PG8_WAIT_V(8); PG8_WAIT_L(0); PG8_BAR; PG8_MMA(1, 0, At, B0); PG8_MMA(1, 1, At, B1); PG8_BAR; PG8_SCHED;
            PG8_LDB(B0, 1, 0); PG8_LDB(B1, 1, 1); PG8_SCHED; PG8_LDA(At, 1, 0); PG8_STAGE(PG8_SA(0, 1), a2, vA1);
            PG8_WAIT_V(8); PG8_WAIT_L(0); PG8_BAR; PG8_MMA(0, 0, At, B0); PG8_MMA(0, 1, At, B1); PG8_BAR; PG8_SCHED;
            PG8_LDA(At, 1, 1); PG8_STAGE(PG8_SB(1, 0), b3, voffB); PG8_STAGE(PG8_SB(1, 1), b3 + hstep, voffB); PG8_STAGE(PG8_SA(1, 0), a3, vA0);
            PG8_WAIT_V(8); PG8_WAIT_L(0); PG8_BAR; PG8_MMA(1, 0, At, B0); PG8_MMA(1, 1, At, B1); PG8_BAR; PG8_SCHED;
        }
        if (wr == 0) PG8_BAR;
        { int ln; asm volatile("v_mbcnt_lo_u32_b32 %0, -1, 0\n\tv_mbcnt_hi_u32_b32 %0, -1, %0" : "=v"(ln));
          pr.epi(acc, cur, wr, wc, ln & 15, ln >> 4); }
        if (!has_next) break;
#pragma unroll
        for (int a = 0; a < 2; ++a)
#pragma unroll
            for (int b = 0; b < 2; ++b)
#pragma unroll
                for (int m = 0; m < 4; ++m)
#pragma unroll
                    for (int n = 0; n < 2; ++n) acc[a][b][m][n] = (f32x4){0.f, 0.f, 0.f, 0.f};
        cur = nxt; cB = nB; ++ui;
        if (wr == 1) PG8_BAR;
    }
    PG8_WAIT_V(0);
    PG8_BAR;
#undef PG8_SA
#undef PG8_SB
#undef PG8_STAGE
#undef PG8_LDA
#undef PG8_LDB
#undef PG8_MMA
#undef PG8_WAIT_V
#undef PG8_WAIT_L
#undef PG8_BAR
#undef PG8_SCHED
}
template <class P>
__device__ __forceinline__ void gemm_phase8(LAS unsigned char* lds, const P& pr, const int tid) {
    constexpr int K = P::K;
    constexpr int nt = K / 128;
    const int wid = __builtin_amdgcn_readfirstlane(tid >> 6), wr = wid >> 2, wc = wid & 3, lane = tid & 63, fr = lane & 15, fq = lane >> 4;
    unsigned voffB[2];
#pragma unroll
    for (int i = 0; i < 2; ++i) { int R, C; stage_rc(tid * 16 + i * 8192, R, C); const int Rb = P::PERM ? ((R & ~31) + perm32(R & 31)) : R; voffB[i] = (unsigned)(Rb * K + 2 * C); }
    const size_t kstep = (size_t)(BK * 2);
    const size_t hstep = (size_t)HALF * K;
    const unsigned ldsw = (unsigned)wid * 1024u;
    const int aoff = lds_byte(wr * 64 + fr, (fq & 1) * 16) + (fq >> 1) * 1024, boff = lds_byte(wc * 32 + fr, (fq & 1) * 16) + (fq >> 1) * 1024;
#define PG8_SA(b, h) (((b) * 2 + (h)) * HTB)
#define PG8_SB(b, h) ((4 + (b) * 2 + (h)) * HTB)
#define PG8_STAGE(bufoff, gbase, voff) do { _Pragma("unroll") for (int _i = 0; _i < 2; ++_i) \
        __builtin_amdgcn_global_load_lds((const unsigned*)((const char*)(gbase) + (voff)[_i]), (LAS unsigned*)(lds + (bufoff) + ldsw + _i * 8192), 16, 0, 0); } while (0)
#define PG8_LD32(dst, base) do { typedef int i32x4_ __attribute__((ext_vector_type(4))); const i32x4_ _lo = *(const LAS i32x4_*)(lds + (base)), _hi = *(const LAS i32x4_*)(lds + (base) + 16); \
        dst = __builtin_shufflevector(_lo, _hi, 0, 1, 2, 3, 4, 5, 6, 7); } while (0)
#define PG8_LDA(dst, b, h) do { _Pragma("unroll") for (int m = 0; m < 4; ++m) PG8_LD32(dst[m], PG8_SA(b, h) + aoff + m * 2048); } while (0)
#define PG8_LDB(dst, b, h) do { _Pragma("unroll") for (int n = 0; n < 2; ++n) PG8_LD32(dst[n], PG8_SB(b, h) + boff + n * 2048); } while (0)
#define PG8_MMA(ai, bj, At, Bt) do { __builtin_amdgcn_s_setprio(1); _Pragma("unroll") for (int m = 0; m < 4; ++m) _Pragma("unroll") for (int n = 0; n < 2; ++n) \
        acc[ai][bj][m][n] = __builtin_amdgcn_mfma_scale_f32_16x16x128_f8f6f4(Bt[n], At[m], acc[ai][bj][m][n], 0, 0, 0, 0x7F7F7F7F, 0, 0x7F7F7F7F); __builtin_amdgcn_s_setprio(0); } while (0)
#define PG8_WAIT_V(n) asm volatile("s_waitcnt vmcnt(" #n ")" ::: "memory")
#define PG8_WAIT_L(n) asm volatile("s_waitcnt lgkmcnt(" #n ")" ::: "memory")
#define PG8_BAR __builtin_amdgcn_s_barrier()
#define PG8_SCHED __builtin_amdgcn_sched_barrier(0)
    Unit cur, nxt; int ui = 0;
    if (!pr.next(0, cur)) return;
    f32x4 acc[2][2][4][2];
#pragma unroll
    for (int a = 0; a < 2; ++a)
#pragma unroll
        for (int b = 0; b < 2; ++b)
#pragma unroll
            for (int m = 0; m < 4; ++m)
#pragma unroll
                for (int n = 0; n < 2; ++n) acc[a][b][m][n] = (f32x4){0.f, 0.f, 0.f, 0.f};
    i32x8 At[4], B0[2], B1[2];
    unsigned vA0[2], vA1[2];
#pragma unroll
    for (int i = 0; i < 2; ++i) { int R, C; stage_rc(tid * 16 + i * 8192, R, C); vA0[i] = (unsigned)(pr.a_row(cur, R) * K + 2 * C); vA1[i] = (unsigned)(pr.a_row(cur, HALF + R) * K + 2 * C); }
    const char* Ab = (const char*)pr.A;
    const char* cB = (const char*)pr.b_tile(cur);
    PG8_STAGE(PG8_SB(0, 0), cB, voffB); PG8_STAGE(PG8_SB(0, 1), cB + hstep, voffB); PG8_STAGE(PG8_SA(0, 0), Ab, vA0); PG8_STAGE(PG8_SA(0, 1), Ab, vA1);
    if (wr == 1) PG8_BAR;
    PG8_WAIT_V(2); PG8_BAR;
    PG8_STAGE(PG8_SB(1, 0), cB + kstep, voffB); PG8_STAGE(PG8_SA(1, 0), Ab + kstep, vA0); PG8_STAGE(PG8_SB(1, 1), cB + hstep + kstep, voffB);
    PG8_WAIT_V(6); PG8_BAR;
    for (;;) {
        const bool has_next = pr.next(ui + 1, nxt);
        const char* nB = has_next ? (const char*)pr.b_tile(nxt) : cB;
        int ridx[2][2] = {{0, 0}, {0, 0}};
        if constexpr (P::GATHER) { if (has_next) { const int* ip = pr.a_idx_ptr(nxt);
            int ln; asm volatile("v_mbcnt_lo_u32_b32 %0, -1, 0\n\tv_mbcnt_hi_u32_b32 %0, -1, %0" : "=v"(ln)); const int tid2 = wid * 64 + ln;
#pragma unroll
            for (int i = 0; i < 2; ++i) { int R, C; stage_rc(tid2 * 16 + i * 8192, R, C); ridx[0][i] = ip[R]; ridx[1][i] = ip[HALF + R]; } } }
#pragma unroll 1
        for (int t = 0; t < nt; t += 2) {
            const bool last = (t == nt - 2);
            const char* a1 = Ab + (size_t)(t + 1) * kstep;
            const char* a2 = last ? Ab : Ab + (size_t)(t + 2) * kstep; const char* b2 = last ? nB : cB + (size_t)(t + 2) * kstep;
            const char* a3 = a2 + kstep; const char* b3 = b2 + kstep;
            PG8_LDB(B0, 0, 0); PG8_LDB(B1, 0, 1); PG8_SCHED; PG8_LDA(At, 0, 0); PG8_STAGE(PG8_SA(1, 1), a1, vA1);
            if (last && has_next) {
#pragma unroll
                for (int i = 0; i < 2; ++i) { int R, C; stage_rc(tid * 16 + i * 8192, R, C);
                    if constexpr (P::GATHER) { vA0[i] = (unsigned)(ridx[0][i] * K + 2 * C); vA1[i] = (unsigned)(ridx[1][i] * K + 2 * C); }
                    else { vA0[i] = (unsigned)(pr.a_row(nxt, R) * K + 2 * C); vA1[i] = (unsigned)(pr.a_row(nxt, HALF + R) * K + 2 * C); } }
            }
            PG8_WAIT_V(8); PG8_WAIT_L(0); PG8_BAR; PG8_MMA(0, 0, At, B0); PG8_MMA(0, 1, At, B1); PG8_BAR; PG8_SCHED;
            PG8_LDA(At, 0, 1); PG8_STAGE(PG8_SB(0, 0), b2, voffB); PG8_STAGE(PG8_SB(0, 1), b2 + hstep, voffB); PG8_STAGE(PG8_SA(0, 0), a2, vA0);
            PG8_WAIT_V(8); PG8_WAIT_L(0); PG8_BAR; PG8_MMA(1, 0, At, B0); PG8_MMA(1, 1, At, B1); PG8_BAR; PG8_SCHED;
            PG8_LDB(B0, 1, 0); PG8_LDB(B1, 1, 1); PG8_SCHED; PG8_LDA(At, 1, 0); PG8_STAGE(PG8_SA(0, 1), a2, vA1);
            PG8_WAIT_V(8); PG8_WAIT_L(0); PG8_BAR; PG8_MMA(0, 0, At, B0); PG8_MMA(0, 1, At, B1); PG8_BAR; PG8_SCHED;
            PG8_LDA(At, 1, 1); PG8_STAGE(PG8_SB(1, 0), b3, voffB); PG8_STAGE(PG8_SB(1, 1), b3 + hstep, voffB); PG8_STAGE(PG8_SA(1, 0), a3, vA0);
            PG8_WAIT_V(8); PG8_WAIT_L(0); PG8_BAR; PG8_MMA(1, 0, At, B0); PG8_MMA(1, 1, At, B1); PG8_BAR; PG8_SCHED;
        }
        if (wr == 0) PG8_BAR;
        { int ln; asm volatile("v_mbcnt_lo_u32_b32 %0, -1, 0\n\tv_mbcnt_hi_u32_b32 %0, -1, %0" : "=v"(ln));
          pr.epi(acc, cur, wr, wc, ln & 15, ln >> 4); }
        if (!has_next) break;
#pragma unroll
        for (int a = 0; a < 2; ++a)
#pragma unroll
            for (int b = 0; b < 2; ++b)
#pragma unroll
                for (int m = 0; m < 4; ++m)
#pragma unroll
                    for (int n = 0; n < 2; ++n) acc[a][b][m][n] = (f32x4){0.f, 0.f, 0.f, 0.f};
        cur = nxt; cB = nB; ++ui;
        if (wr == 1) PG8_BAR;
    }
    PG8_WAIT_V(0);
    PG8_BAR;
#undef PG8_SA
#undef PG8_SB
#undef PG8_STAGE
#undef PG8_LD32
#undef PG8_LDA
#undef PG8_LDB
#undef PG8_MMA
#undef PG8_WAIT_V
#undef PG8_WAIT_L
#undef PG8_BAR
#undef PG8_SCHED
}
}

typedef f32x4 AccT[2][2][4][2];

struct DenseOrder {
    int nM, nN, nx, x, li, cpx;
    __device__ __forceinline__ void init(int nM_, int nN_, int G, int blk) { nM = nM_; nN = nN_; nx = (G % 8 == 0) ? 8 : 1; x = blk % nx; li = blk / nx; cpx = G / nx; }
    __device__ __forceinline__ bool next(int i, pg8::Unit& u) const {
        const int npx = (nM - x + nx - 1) / nx, lu = i * cpx + li; if (lu >= npx * nN) return false;
        u.pm = (lu / nN) * nx + x; u.pn = lu % nN; u.e = 0; return true; }
};
struct MoeOrder {
    int npan, nN, nx, x, li, cpx;
    __device__ __forceinline__ void init(int npan_, int nN_, int G, int blk) { npan = npan_; nN = nN_; nx = (G % 8 == 0) ? 8 : 1; x = blk % nx; li = blk / nx; cpx = G / nx; }
    __device__ __forceinline__ bool next(int i, pg8::Unit& u) const {
        const int per = npan * nN, lu = i * cpx + li; if (lu >= (NE / nx) * per) return false;
        const int el = lu / per, rem = lu % per; u.e = el * nx + x; u.pm = rem / nN; u.pn = rem % nN; return true; }
};

struct ProbQKV {
    static constexpr int K = 1024; static constexpr bool PERM = true, GATHER = false;
    const bf16_t* A; const bf16_t* Bt; bf16_t* O; const float* rope; DenseOrder ord;
    __device__ __forceinline__ bool next(int i, pg8::Unit& u) const { return ord.next(i, u); }
    __device__ __forceinline__ int a_row(const pg8::Unit& u, int r) const { return u.pm * 256 + r; }
    __device__ __forceinline__ const int* a_idx_ptr(const pg8::Unit&) const { return nullptr; }
    __device__ __forceinline__ const bf16_t* b_tile(const pg8::Unit& u) const { return Bt + (size_t)u.pn * 256 * K; }
    __device__ __forceinline__ void epi(const AccT& acc, const pg8::Unit& u, int wr, int wc, int fr, int fq) const {
        const bool dorope = (u.pn < 8) && (u.pm < 128);
#pragma unroll
        for (int ai = 0; ai < 2; ++ai)
#pragma unroll
            for (int m = 0; m < 4; ++m) {
                const int row = u.pm * 256 + ai * 128 + wr * 64 + m * 16 + fr; const int t = row & 2047;
                f32x4 c0 = {1.f, 0.f, 1.f, 0.f}, c1 = {1.f, 0.f, 1.f, 0.f};
                if (dorope) { const float* rp = rope + ((size_t)t * 32 + (((wc & 1) * 32 + 8 * fq) >> 1)) * 2; c0 = *(const f32x4*)rp; c1 = *(const f32x4*)(rp + 4); }
#pragma unroll
                for (int bj = 0; bj < 2; ++bj) {
                    const int col = u.pn * 256 + bj * 128 + wc * 32 + 8 * fq;
                    f32x4 v0 = acc[ai][bj][m][0], v1 = acc[ai][bj][m][1];
                    if (dorope) {
                        f32x4 o0, o1;
                        o0[0] = v0[0] * c0[0] - v0[1] * c0[1]; o0[1] = v0[0] * c0[1] + v0[1] * c0[0];
                        o0[2] = v0[2] * c0[2] - v0[3] * c0[3]; o0[3] = v0[2] * c0[3] + v0[3] * c0[2];
                        o1[0] = v1[0] * c1[0] - v1[1] * c1[1]; o1[1] = v1[0] * c1[1] + v1[1] * c1[0];
                        o1[2] = v1[2] * c1[2] - v1[3] * c1[3]; o1[3] = v1[2] * c1[3] + v1[3] * c1[2];
                        v0 = o0; v1 = o1;
                    }
                    u32x4 w; w.x = cvt_pk_bf16(v0[0], v0[1]); w.y = cvt_pk_bf16(v0[2], v0[3]); w.z = cvt_pk_bf16(v1[0], v1[1]); w.w = cvt_pk_bf16(v1[2], v1[3]);
                    *(u32x4*)(O + (size_t)row * 3072 + col) = w;
                }
            }
    }
};

template <bool GLU> struct ProbResid {
    static constexpr int K = 1024; static constexpr bool PERM = false, GATHER = false; static constexpr bool F8 = GLU ? (GLU_FP8 != 0) : (WO_FP8 != 0);
    const unsigned char* A; const unsigned char* Bt; bf16_t* X; const float* Xlat; const float* Xctx; bool in_f32; const float* gate; DenseOrder ord;
    __device__ __forceinline__ bool next(int i, pg8::Unit& u) const { return ord.next(i, u); }
    __device__ __forceinline__ int a_row(const pg8::Unit& u, int r) const { return u.pm * 256 + r; }
    __device__ __forceinline__ const int* a_idx_ptr(const pg8::Unit&) const { return nullptr; }
    __device__ __forceinline__ const unsigned char* b_tile(const pg8::Unit& u) const { return Bt + (size_t)u.pn * 256 * K * (F8 ? 1 : 2); }
    __device__ __forceinline__ void epi(const AccT& acc, const pg8::Unit& u, int wr, int wc, int fr, int fq) const {
        constexpr float S8 = F8 ? A8_INV * W8_INV : 1.0f;
        const int s = (u.pm < 128) ? (u.pm >> 3) : 16; const float* gp = gate + (size_t)s * NMOD;
        f32x4 gv[2][2];
#pragma unroll
        for (int bj = 0; bj < 2; ++bj)
#pragma unroll
            for (int n = 0; n < 2; ++n) gv[bj][n] = *(const f32x4*)(gp + (GLU ? u.pn * 128 : u.pn * 256 + bj * 128) + wc * 32 + 16 * n + 4 * fq) * S8;
#pragma unroll
        for (int ai = 0; ai < 2; ++ai)
#pragma unroll
            for (int m = 0; m < 4; ++m) {
                const int row = u.pm * 256 + ai * 128 + wr * 64 + m * 16 + fr;
                bf16_t* xr = X + (size_t)row * D; const float* xs = (u.pm < 128) ? Xlat + (size_t)row * D : Xctx + (size_t)(row - NLAT) * D;
#define RES_LD(col) (in_f32 ? *(const f32x4*)(xs + (col)) : bf4_unpack(*(const u32x2*)(xr + (col))))
                if constexpr (GLU) {
#pragma unroll
                    for (int n = 0; n < 2; ++n) { const int col = u.pn * 128 + wc * 32 + 16 * n + 4 * fq;
                        const f32x4 a = acc[ai][0][m][n], b = acc[ai][1][m][n], g = gv[0][n]; f32x4 xv = RES_LD(col);
                        xv[0] += g[0] * a[0] * sigmoidf_(b[0] * S8); xv[1] += g[1] * a[1] * sigmoidf_(b[1] * S8); xv[2] += g[2] * a[2] * sigmoidf_(b[2] * S8); xv[3] += g[3] * a[3] * sigmoidf_(b[3] * S8);
                        *(u32x2*)(xr + col) = bf4_pack(xv); }
                } else {
#pragma unroll
                    for (int bj = 0; bj < 2; ++bj)
#pragma unroll
                        for (int n = 0; n < 2; ++n) { const int col = u.pn * 256 + bj * 128 + wc * 32 + 16 * n + 4 * fq;
                            const f32x4 a = acc[ai][bj][m][n], g = gv[bj][n]; f32x4 xv = RES_LD(col);
                            xv += g * a; *(u32x2*)(xr + col) = bf4_pack(xv); }
                }
#undef RES_LD
            }
    }
};

struct ProbMoe1 {
    static constexpr int K = 1024; static constexpr bool PERM = true, GATHER = true;
    const unsigned char* A; const unsigned char* Bt; void* O; const int* midx; MoeOrder ord;
    __device__ __forceinline__ bool next(int i, pg8::Unit& u) const { return ord.next(i, u); }
    __device__ __forceinline__ int a_row(const pg8::Unit& u, int r) const { return midx[u.e * EROWS + u.pm * 256 + r]; }
    __device__ __forceinline__ const int* a_idx_ptr(const pg8::Unit& u) const { return midx + u.e * EROWS + u.pm * 256; }
    __device__ __forceinline__ const unsigned char* b_tile(const pg8::Unit& u) const { return Bt + ((size_t)u.e * 4096 + (size_t)u.pn * 256) * K; }
    __device__ __forceinline__ void epi(const AccT& acc, const pg8::Unit& u, int wr, int wc, int fr, int fq) const {
        constexpr float S = H8_INV * W8_INV, ZC = -S * 1.4426950408889634f, HC = S * S * HID8_SCALE;
#pragma unroll
        for (int ai = 0; ai < 2; ++ai)
#pragma unroll
            for (int m = 0; m < 4; ++m) {
                const size_t row = (size_t)u.e * EROWS + u.pm * 256 + ai * 128 + wr * 64 + m * 16 + fr; const int col = u.pn * 128 + wc * 32 + 8 * fq;
                float h[8];
                constexpr float HCI = 1.0f / HC;
#pragma unroll
                for (int n = 0; n < 2; ++n) {
                    const f32x4 g = acc[ai][0][m][n], up = acc[ai][1][m][n];
#pragma unroll
                    for (int k = 0; k < 4; k += 2) {
                        const f32x2 g2 = {g[k], g[k + 1]}, u2 = {up[k], up[k + 1]};
                        const f32x2 t2 = g2 * u2, z2 = g2 * ZC;
                        f32x2 e2; e2[0] = __builtin_amdgcn_exp2f(z2[0]); e2[1] = __builtin_amdgcn_exp2f(z2[1]);
                        const f32x2 d2 = __builtin_elementwise_fma(e2, (f32x2){HCI, HCI}, (f32x2){HCI, HCI});
                        f32x2 r2; r2[0] = __builtin_amdgcn_rcpf(d2[0]); r2[1] = __builtin_amdgcn_rcpf(d2[1]);
                        const f32x2 h2 = t2 * r2; h[n * 4 + k] = h2[0]; h[n * 4 + k + 1] = h2[1];
                    }
                }
#if MOE2_FP8
                u32x2 w; w.x = pk4_fp8(h[0], h[1], h[2], h[3]); w.y = pk4_fp8(h[4], h[5], h[6], h[7]);
                *(u32x2*)((unsigned char*)O + row * FF + col) = w;
#else
                u32x4 w; w.x = cvt_pk_bf16(h[0] * HID8_INV, h[1] * HID8_INV); w.y = cvt_pk_bf16(h[2] * HID8_INV, h[3] * HID8_INV); w.z = cvt_pk_bf16(h[4] * HID8_INV, h[5] * HID8_INV); w.w = cvt_pk_bf16(h[6] * HID8_INV, h[7] * HID8_INV);
                *(u32x4*)((bf16_t*)O + row * FF + col) = w;
#endif
            }
    }
};
struct ProbMoe2 {
    static constexpr int K = 2048; static constexpr bool PERM = true, GATHER = false;
    const void* A; const void* Bt; bf16_t* O; MoeOrder ord;
    __device__ __forceinline__ bool next(int i, pg8::Unit& u) const { return ord.next(i, u); }
    __device__ __forceinline__ int a_row(const pg8::Unit& u, int r) const { return u.e * EROWS + u.pm * 256 + r; }
    __device__ __forceinline__ const int* a_idx_ptr(const pg8::Unit&) const { return nullptr; }
#if MOE2_FP8
    __device__ __forceinline__ const unsigned char* b_tile(const pg8::Unit& u) const { return (const unsigned char*)Bt + ((size_t)u.e * 1024 + (size_t)u.pn * 256) * K; }
#else
    __device__ __forceinline__ const bf16_t* b_tile(const pg8::Unit& u) const { return (const bf16_t*)Bt + ((size_t)u.e * 1024 + (size_t)u.pn * 256) * K; }
#endif
    __device__ __forceinline__ void epi(const AccT& acc, const pg8::Unit& u, int wr, int wc, int fr, int fq) const {
        constexpr float S = MOE2_FP8 ? HID8_INV * W8_INV : 1.0f;
#pragma unroll
        for (int ai = 0; ai < 2; ++ai)
#pragma unroll
            for (int m = 0; m < 4; ++m) {
                const size_t row = (size_t)u.e * EROWS + u.pm * 256 + ai * 128 + wr * 64 + m * 16 + fr;
#pragma unroll
                for (int bj = 0; bj < 2; ++bj) { const int col = u.pn * 256 + bj * 128 + wc * 32 + 8 * fq; const f32x4 v0 = acc[ai][bj][m][0] * (S * Y8_SCALE), v1 = acc[ai][bj][m][1] * (S * Y8_SCALE);
                    u32x2 w; w.x = pk4_fp8(v0[0], v0[1], v0[2], v0[3]); w.y = pk4_fp8(v1[0], v1[1], v1[2], v1[3]);
                    *(u32x2*)((unsigned char*)O + row * D + col) = w; }
            }
    }
};

namespace att {
constexpr int KVBLK = 64; constexpr float SCALE = 0.125f, THR = 8.f;
constexpr int SHM_V = KVBLK * 128 * 2, SHM_K = KVBLK * 128 * 2;
constexpr int EXS = 132;
constexpr int EX_BYTES = 2 * 128 * EXS * 4;
constexpr int WS_OFF = EX_BYTES;
static_assert(3 * SHM_V + 3 * SHM_K <= EX_BYTES, "K/V buffers inside exchange region");
static_assert(LDS_SCR + WS_OFF + 8 * 64 * 4 <= LDS_BYTES, "attention LDS");
#define KSWZ(row, colB) ((row) * 256 + ((colB) ^ (((row) & 7) << 4)))
#define SBAR() __builtin_amdgcn_sched_barrier(0)
__device__ __forceinline__ int crow(int r, int hi) { return (r & 3) + 8 * (r >> 2) + 4 * hi; }
__device__ __forceinline__ void partialSM(f32x16& p0, f32x16& p1, float& m_reg, float& mn, float& alpha) {
    constexpr float THR2 = THR * 1.4426950408889634f;
    float pmax = p0[0];
#pragma unroll
    for (int r = 1; r < 16; ++r) pmax = fmaxf(pmax, p0[r]);
#pragma unroll
    for (int r = 0; r < 16; ++r) pmax = fmaxf(pmax, p1[r]);
    { auto rr = __builtin_amdgcn_permlane32_swap(__float_as_uint(pmax), __float_as_uint(pmax), false, false);
      pmax = fmaxf(__uint_as_float(rr[0]), __uint_as_float(rr[1])); }
    if (__builtin_expect(__all(m_reg == 0.f && pmax <= THR2), 1)) { alpha = 1.f; }
    else {
        const float newm = (pmax - m_reg > THR2) ? fmaxf(m_reg, pmax) : m_reg;
        alpha = __builtin_amdgcn_exp2f(m_reg - newm); m_reg = newm;
#pragma unroll
        for (int r = 0; r < 16; ++r) { p0[r] -= newm; p1[r] -= newm; }
    }
    mn = m_reg;
#pragma unroll
    for (int r = 0; r < 16; ++r) p0[r] = __builtin_amdgcn_exp2f(p0[r]);
}
__device__ __forceinline__ void finishSM(f32x16& p0, f32x16& p1, float alpha, float& l_reg, bf16x8& pa0, bf16x8& pa1, bf16x8& pa2, bf16x8& pa3) {
#pragma unroll
    for (int r = 0; r < 16; ++r) p1[r] = __builtin_amdgcn_exp2f(p1[r]);
    float ps = 0;
#pragma unroll
    for (int r = 0; r < 16; ++r) ps += p0[r];
#pragma unroll
    for (int r = 0; r < 16; ++r) ps += p1[r];
    { auto rr = __builtin_amdgcn_permlane32_swap(__float_as_uint(ps), __float_as_uint(ps), false, false);
      ps = __uint_as_float(rr[0]) + __uint_as_float(rr[1]); }
    l_reg = l_reg * alpha + ps;
#define PK4(P, BASE, OUT) do { unsigned a0 = cvt_pk_bf16(P[BASE + 0], P[BASE + 1]), a1 = cvt_pk_bf16(P[BASE + 2], P[BASE + 3]);   \
    unsigned b0 = cvt_pk_bf16(P[BASE + 4], P[BASE + 5]), b1 = cvt_pk_bf16(P[BASE + 6], P[BASE + 7]);                              \
    auto r0 = __builtin_amdgcn_permlane32_swap(a0, b0, false, false); auto r1 = __builtin_amdgcn_permlane32_swap(a1, b1, false, false); \
    u32x4 w = {r0[0], r1[0], r0[1], r1[1]}; OUT = *reinterpret_cast<bf16x8*>(&w); } while (0)
    PK4(p0, 0, pa0); PK4(p0, 8, pa1); PK4(p1, 0, pa2); PK4(p1, 8, pa3);
#undef PK4
}
__device__ __forceinline__ void qkt(f32x16& p0, f32x16& p1, const LAS char* Ks, const bf16x8* qr, int r32, int hi, int cofs) {
    p0 = f32x16{}; p1 = f32x16{};
#pragma unroll
    for (int d0 = 0; d0 < 4; ++d0) { const int cb = cofs + (d0 * 16 + hi * 8) * 2;
        const bf16x8 b0 = *reinterpret_cast<const LAS bf16x8*>(Ks + KSWZ(r32, cb));
        const bf16x8 b1 = *reinterpret_cast<const LAS bf16x8*>(Ks + KSWZ(32 + r32, cb));
        p0 = __builtin_amdgcn_mfma_f32_32x32x16_bf16(b0, qr[d0], p0, 0, 0, 0);
        p1 = __builtin_amdgcn_mfma_f32_32x32x16_bf16(b1, qr[d0], p1, 0, 0, 0); }
}
__device__ __forceinline__ int v_st(int k, int c) { const int kk = (k & ~0xC) | ((k & 4) << 1) | ((k & 8) >> 1); return ((kk >> 3) * 4 + (c >> 5)) * 512 + ((kk & 7) * 32 + (c & 31)) * 2; }
__device__ __forceinline__ int v_rd_base(int lane) { return ((lane & 3) << 3) | (((lane >> 2) & 3) << 6) | (((lane >> 4) & 1) << 5) | (((lane >> 5) & 1) << 8); }
constexpr int v_rd_off(int d0, int ks, int half) { return d0 * 512 + ks * 4096 + half * 2048; }
template <int OFF> __device__ __forceinline__ s16x4 tr_read(int vb) {
    s16x4 r; asm volatile("ds_read_b64_tr_b16 %0, %1 offset:%2" : "=&v"(r) : "v"(vb), "i"(OFF) : "memory"); return r;
}
template <int D0> __device__ __forceinline__ void pv_one(f32x16& od, int vb, bf16x8 pa0, bf16x8 pa1, bf16x8 pa2, bf16x8 pa3) {
    const s16x4 l0 = tr_read<v_rd_off(D0, 0, 0)>(vb), h0 = tr_read<v_rd_off(D0, 0, 1)>(vb), l1 = tr_read<v_rd_off(D0, 1, 0)>(vb), h1 = tr_read<v_rd_off(D0, 1, 1)>(vb);
    const s16x4 l2 = tr_read<v_rd_off(D0, 2, 0)>(vb), h2 = tr_read<v_rd_off(D0, 2, 1)>(vb), l3 = tr_read<v_rd_off(D0, 3, 0)>(vb), h3 = tr_read<v_rd_off(D0, 3, 1)>(vb);
    asm volatile("s_waitcnt lgkmcnt(0)" ::: "memory"); SBAR();
#define PK(L, H) (bf16x8){L[0], L[1], L[2], L[3], H[0], H[1], H[2], H[3]}
    od = __builtin_amdgcn_mfma_f32_32x32x16_bf16(pa0, PK(l0, h0), od, 0, 0, 0);
    od = __builtin_amdgcn_mfma_f32_32x32x16_bf16(pa1, PK(l1, h1), od, 0, 0, 0);
    od = __builtin_amdgcn_mfma_f32_32x32x16_bf16(pa2, PK(l2, h2), od, 0, 0, 0);
    od = __builtin_amdgcn_mfma_f32_32x32x16_bf16(pa3, PK(l3, h3), od, 0, 0, 0);
#undef PK
}
__device__ __forceinline__ void pv_d0(f32x16* o, int vb, bf16x8 pa0, bf16x8 pa1, bf16x8 pa2, bf16x8 pa3) {
    pv_one<0>(o[0], vb, pa0, pa1, pa2, pa3); pv_one<1>(o[1], vb, pa0, pa1, pa2, pa3); pv_one<2>(o[2], vb, pa0, pa1, pa2, pa3); pv_one<3>(o[3], vb, pa0, pa1, pa2, pa3);
}

__device__ __forceinline__ void unit(const bf16_t* __restrict__ QKVb, bf16_t* __restrict__ AOb, int qrow0, int h, int klat0, int ntl, int kctx0, int NT,
                                     float lam, float oscale, const float* __restrict__ subg, LAS char* lds, const int wave_s) {
    int lane_f; asm volatile("v_mbcnt_lo_u32_b32 %0, -1, 0\n\tv_mbcnt_hi_u32_b32 %0, -1, %0" : "=v"(lane_f));
    const int tid = wave_s * 64 + lane_f;
    const int wid = tid >> 6, lane = tid & 63, r32 = lane & 31, hi = lane >> 5, comp = wid >> 2, wq = wid & 3;
    LAS char* V_lds = lds; LAS char* K_lds = lds + 3 * SHM_V;
    LAS float* wsl = (LAS float*)(lds + WS_OFF) + wid * 64; LAS float* li_l = wsl; LAS float* al_l = wsl + 32;
    float m_reg = 0.f, l_reg = 0; f32x16 o[4] = {}; bf16x8 qr[4];
    const bf16_t* Qw = QKVb + (size_t)(qrow0 + wq * 32 + r32) * 3072 + h * 128 + comp * 64 + hi * 8;
#pragma unroll
    for (int d0 = 0; d0 < 4; ++d0) qr[d0] = *reinterpret_cast<const bf16x8*>(Qw + d0 * 16);
    const int cofs = comp * 128;
    const int sr = tid >> 4, sc = (tid & 15) * 8, vst0 = v_st(sr, sc), vst1 = v_st(32 + sr, sc);
    const int vb0 = (int)(uintptr_t)V_lds + v_rd_base(lane);
    const bf16_t* Kc = QKVb + 1024 + h * 128 + sc; const bf16_t* Vc = QKVb + 2048 + h * 128 + sc;
    struct { bf16x8 vs0, vs1, ks0, ks1; } sr_[2];
#define KROW(j) (((j) < ntl) ? (klat0 + (j) * 64) : (kctx0 + ((j) - ntl) * 64))
#define SLOAD(i, j) do { const size_t _r = (size_t)(KROW(j) + sr) * 3072; sr_[i].vs0 = *reinterpret_cast<const bf16x8*>(Vc + _r); sr_[i].vs1 = *reinterpret_cast<const bf16x8*>(Vc + _r + 32 * 3072); \
    sr_[i].ks0 = *reinterpret_cast<const bf16x8*>(Kc + _r); sr_[i].ks1 = *reinterpret_cast<const bf16x8*>(Kc + _r + 32 * 3072); } while (0)
#define SWRITE(b, i) do { *(LAS bf16x8*)(V_lds + (b) * SHM_V + vst0) = sr_[i].vs0;          \
    *(LAS bf16x8*)(V_lds + (b) * SHM_V + vst1) = sr_[i].vs1; const int kc = sc * 2;               \
    *(LAS bf16x8*)(K_lds + (b) * SHM_K + KSWZ(sr, kc)) = sr_[i].ks0;                       \
    *(LAS bf16x8*)(K_lds + (b) * SHM_K + KSWZ(32 + sr, kc)) = sr_[i].ks1; } while (0)
#define SWAIT() asm volatile("s_waitcnt vmcnt(4)" ::: "memory")
#define RESC(a) do { if (__any((a) < 1.f)) { if (hi == 0) al_l[r32] = (a); asm volatile("s_waitcnt lgkmcnt(0)" ::: "memory"); \
    _Pragma("unroll") for (int d = 0; d < 4; ++d) _Pragma("unroll") for (int r = 0; r < 16; ++r) o[d][r] *= al_l[crow(r, hi)]; } } while (0)
    f32x16 pA0, pA1, pB0, pB1; float mnA, mnB, alA, alB; bf16x8 pa0, pa1, pa2, pa3;
    constexpr int SE = 0, SO = 1;
    SLOAD(SE, 0); asm volatile("s_waitcnt vmcnt(0)" ::: "memory"); SWRITE(0, SE);
    SLOAD(SO, 1); if (2 < NT) SLOAD(SE, 2);
    __syncthreads();
    qkt(pA0, pA1, K_lds, qr, r32, hi, cofs); partialSM(pA0, pA1, m_reg, mnA, alA);
    SWAIT(); SWRITE(1, SO); __syncthreads();
    int bK = 1, bP = 0, bF = 2;
    for (int j = 1; j + 1 < NT; j += 2) {
        SBAR(); qkt(pB0, pB1, K_lds + bK * SHM_K, qr, r32, hi, cofs);
        finishSM(pA0, pA1, alA, l_reg, pa0, pa1, pa2, pa3); SBAR();
        SLOAD(SO, j + 2); SBAR();
        pv_d0(o, vb0 + bP * SHM_V, pa0, pa1, pa2, pa3); partialSM(pB0, pB1, m_reg, mnB, alB);
        SWAIT(); SWRITE(bF, SE);
        RESC(alB); __syncthreads();
        { const int t = bP; bP = bK; bK = bF; bF = t; }
        SBAR(); qkt(pA0, pA1, K_lds + bK * SHM_K, qr, r32, hi, cofs);
        finishSM(pB0, pB1, alB, l_reg, pa0, pa1, pa2, pa3); SBAR();
        if (j + 3 < NT) SLOAD(SE, j + 3); SBAR();
        pv_d0(o, vb0 + bP * SHM_V, pa0, pa1, pa2, pa3); partialSM(pA0, pA1, m_reg, mnA, alA);
        SWAIT(); SWRITE(bF, SO);
        RESC(alA); __syncthreads();
        { const int t = bP; bP = bK; bK = bF; bF = t; }
    }
    SBAR(); qkt(pB0, pB1, K_lds + bK * SHM_K, qr, r32, hi, cofs);
    finishSM(pA0, pA1, alA, l_reg, pa0, pa1, pa2, pa3); SBAR();
    pv_d0(o, vb0 + bP * SHM_V, pa0, pa1, pa2, pa3); partialSM(pB0, pB1, m_reg, mnB, alB);
    RESC(alB);
    finishSM(pB0, pB1, alB, l_reg, pa0, pa1, pa2, pa3); SBAR();
    pv_d0(o, vb0 + bK * SHM_V, pa0, pa1, pa2, pa3);
    if (hi == 0) li_l[r32] = l_reg;
    asm volatile("s_waitcnt vmcnt(0) lgkmcnt(0)" ::: "memory");
    __syncthreads();
    {
        LAS float* ex = (LAS float*)lds + (size_t)comp * 128 * EXS + (size_t)(wq * 32) * EXS;
        float rli[16];
#pragma unroll
        for (int r = 0; r < 16; ++r) rli[r] = 1.0f / li_l[crow(r, hi)];
#pragma unroll
        for (int r = 0; r < 16; ++r) { const int orow = crow(r, hi);
#pragma unroll
            for (int d0 = 0; d0 < 4; ++d0) ex[orow * EXS + d0 * 32 + r32] = o[d0][r] * rli[r]; }
    }
    __syncthreads();
    {
        const int row = tid >> 2, qt = tid & 3;
        const LAS float* e0 = (const LAS float*)lds + (size_t)row * EXS + qt * 32; const LAS float* e1 = e0 + 128 * EXS;
        f32x4 ov[8]; float ss = 0.f;
#pragma unroll
        for (int i = 0; i < 8; ++i) { const f32x4 a = *(const LAS f32x4*)(e0 + i * 4), b = *(const LAS f32x4*)(e1 + i * 4); ov[i] = a - b * lam;
            ss += ov[i][0] * ov[i][0] + ov[i][1] * ov[i][1] + ov[i][2] * ov[i][2] + ov[i][3] * ov[i][3]; }
        ss += __shfl_xor(ss, 1); ss += __shfl_xor(ss, 2);
        const float rs = rsqrtf(ss * (1.0f / 128.0f) + EPS) * oscale;
#if WO_FP8
        unsigned char* op = (unsigned char*)AOb + (size_t)(qrow0 + row) * D + h * 128 + qt * 32;
        const float rs8 = rs * A8_SCALE; unsigned wq[8];
#pragma unroll
        for (int i = 0; i < 4; ++i) { const f32x4 g0 = *(const f32x4*)(subg + qt * 32 + i * 8), g1 = *(const f32x4*)(subg + qt * 32 + i * 8 + 4);
            const f32x4 a = ov[2 * i] * rs8 * g0, b = ov[2 * i + 1] * rs8 * g1;
            wq[2 * i] = pk4_fp8(a[0], a[1], a[2], a[3]); wq[2 * i + 1] = pk4_fp8(b[0], b[1], b[2], b[3]); }
        { u32x4 w0, w1; w0.x = wq[0]; w0.y = wq[1]; w0.z = wq[2]; w0.w = wq[3]; w1.x = wq[4]; w1.y = wq[5]; w1.z = wq[6]; w1.w = wq[7]; *(u32x4*)op = w0; *(u32x4*)(op + 16) = w1; }
#else
        bf16_t* op = AOb + (size_t)(qrow0 + row) * D + h * 128 + qt * 32;
#pragma unroll
        for (int i = 0; i < 4; ++i) { const f32x4 g0 = *(const f32x4*)(subg + qt * 32 + i * 8), g1 = *(const f32x4*)(subg + qt * 32 + i * 8 + 4);
            const f32x4 a = ov[2 * i] * rs * g0, b = ov[2 * i + 1] * rs * g1;
            u32x4 w; w.x = cvt_pk_bf16(a[0], a[1]); w.y = cvt_pk_bf16(a[2], a[3]); w.z = cvt_pk_bf16(b[0], b[1]); w.w = cvt_pk_bf16(b[2], b[3]);
            *(u32x4*)(op + i * 8) = w; }
#endif
    }
    __syncthreads();
#undef KROW
#undef SLOAD
#undef SWRITE
#undef SWAIT
#undef RESC
}
}

__device__ __forceinline__ void p_attention(const Ctx& F, const int j, const int Gc, const int vcu) {
    const float* lv = (const float*)(F.ws + WS_LAM); const float lam = lv[j * 2], oscale = lv[j * 2 + 1];
    const float* subg = F.in[15] + j * 128;
    LAS char* lds = (LAS char*)(F.lds + LDS_SCR);
    for (int i = 0;; ++i) {
        const int U = i * Gc + vcu; if (U >= 2048 + 256) break;
        if (U < 2048) { const int b = U >> 7, rem = U & 127, h = rem >> 4, qb = rem & 15;
            att::unit(F.QKV(), F.AO(), b * 2048 + qb * 128, h, b * 2048, 32, NLAT + b * 256, 36, lam, oscale, subg, lds, F.wave); }
        else { const int q = U - 2048, b = q >> 4, rem = q & 15, h = rem >> 1, qb = rem & 1;
            att::unit(F.QKV(), F.AO(), NLAT + b * 256 + qb * 128, h, 0, 0, NLAT + b * 256, 4, lam, oscale, subg, lds, F.wave); }
    }
}

template <int CTRL> __device__ __forceinline__ float dppz(float x) { return __builtin_bit_cast(float, __builtin_amdgcn_update_dpp(0, __builtin_bit_cast(int, x), CTRL, 0xF, 0xF, true)); }
struct S5K { float ar, as, br, bs, cr, cs, dr, ds, pr, ps; };
__device__ __forceinline__ float s5_swp(float x) { return dppz<0xB1>(x); }
template <int DIR> __device__ __forceinline__ void s5_scan2(const f32x4 E, float& R, const S5K& k, const int lane, float (&xin)[4]) {
#define IX(j) (DIR == 0 ? (j) : 3 - (j))
    float z = E[IX(0)];
    z = fmaf(k.ar, z, fmaf(k.as, s5_swp(z), E[IX(1)])); z = fmaf(k.ar, z, fmaf(k.as, s5_swp(z), E[IX(2)])); z = fmaf(k.ar, z, fmaf(k.as, s5_swp(z), E[IX(3)]));
    const int pq = lane >> 4, gp = DIR == 0 ? pq : 3 - pq;
    const int s1 = DIR == 0 ? lane - 16 : lane + 16, s2 = DIR == 0 ? lane - 32 : lane + 32;
    float S = z, t;
    t = __shfl(S, s1); t = gp >= 1 ? t : 0.f; S = fmaf(k.br, t, fmaf(k.bs, s5_swp(t), S));
    t = __shfl(S, s2); t = gp >= 2 ? t : 0.f; S = fmaf(k.cr, t, fmaf(k.cs, s5_swp(t), S));
    t = __shfl(S, s1); t = gp >= 1 ? t : 0.f;
    const float Ro = s5_swp(R);
    float c = fmaf(k.pr, R, fmaf(k.ps, Ro, t));
    const float sl = __shfl(S, (DIR == 0 ? 48 : 0) + (lane & 15));
    R = fmaf(k.dr, R, fmaf(k.ds, Ro, sl));
    xin[IX(0)] = c;
    c = fmaf(k.ar, c, fmaf(k.as, s5_swp(c), E[IX(0)])); xin[IX(1)] = c;
    c = fmaf(k.ar, c, fmaf(k.as, s5_swp(c), E[IX(1)])); xin[IX(2)] = c;
    c = fmaf(k.ar, c, fmaf(k.as, s5_swp(c), E[IX(2)])); xin[IX(3)] = c;
#undef IX
}
__device__ __forceinline__ S5K s5_consts(const float* ab, const int comp, const int gp) {
    float r = ab[0], i = ab[1];
#define CSQ() { const float nr = r * r - i * i, ni = 2.f * r * i; r = nr; i = ni; }
    CSQ() CSQ() CSQ() CSQ()
    S5K k; const float sg = comp ? 1.f : -1.f;
    k.ar = r; k.as = sg * i;
    CSQ() CSQ()
    const float b_r = r, b_i = i; k.br = r; k.bs = sg * i;
    CSQ()
    const float c_r = r, c_i = i; k.cr = r; k.cs = sg * i;
    CSQ()
    k.dr = r; k.ds = sg * i;
#undef CSQ
    const float e_r = b_r * c_r - b_i * c_i, e_i = b_r * c_i + b_i * c_r;
    const float p_r = gp == 0 ? 1.f : gp == 1 ? b_r : gp == 2 ? c_r : e_r, p_i = gp == 0 ? 0.f : gp == 1 ? b_i : gp == 2 ? c_i : e_i;
    k.pr = p_r; k.ps = sg * p_i;
    return k;
}
__device__ __forceinline__ void p_s5ssd(const Ctx& F, const int j2, const bool ctx_out) {
    const int lane = F.lane, w = F.wave;
    LAS char* UL = (LAS char*)(F.lds + LDS_SCR);
    LAS char* XL = UL + 144 * 528;
#pragma unroll 1
    for (int item = F.blk; item < 256; item += F.G) {
        const int g = 8 * (item & 7) + (item >> 5), bq = (item >> 3) & 3, it = j2 * 64 + g;
        int lane1 = lane, tid1 = F.tid; asm volatile("" : "+v"(lane1), "+v"(tid1));
        const int l16 = lane1 & 15, pq = lane1 >> 4;
        u32x4 pre[9];
#define S5_PRELOAD(bb) { const bf16_t* Hb = F.H(); _Pragma("unroll") for (int i = 0; i < 9; ++i) { const int idx = tid1 + 512 * i, ti = idx >> 1, hf = idx & 1; \
            const size_t row = ti < 256 ? (size_t)(NLAT + (bb) * 256 + ti) : (size_t)((bb) * 2048 + ti - 256); pre[i] = *(const u32x4*)(Hb + row * D + g * 16 + hf * 8); } }
        S5_PRELOAD(bq * 4)
        const S5K kf = s5_consts((const float*)(F.ws + WS_S5AB) + ((size_t)((j2 * 2 + 0) * 64 + g) * 64 + 8 * w + (l16 >> 1)) * 2, l16 & 1, pq);
        const S5K kb = s5_consts((const float*)(F.ws + WS_S5AB) + ((size_t)((j2 * 2 + 1) * 64 + g) * 64 + 8 * w + (l16 >> 1)) * 2, l16 & 1, 3 - pq);
#pragma unroll 1
        for (int bi = 0; bi < 4; ++bi) {
            const int b = bq * 4 + bi;
            int lane2 = lane1, tid2 = tid1; asm volatile("" : "+v"(lane2), "+v"(tid2));
            const int m16 = lane2 & 15, mq = lane2 >> 4;
            bf16x8 Wf[8], Wb[8];
            { const bf16x8* tp = (const bf16x8*)(F.ws + WS_S5T1 + (size_t)it * 131072) + (size_t)(w * 8) * 64 + lane2;
#pragma unroll
              for (int kk = 0; kk < 8; ++kk) { Wf[kk] = tp[kk * 64]; Wb[kk] = tp[(64 + kk) * 64]; } }
            __syncthreads();
#pragma unroll
            for (int i = 0; i < 9; ++i) { const int idx = tid2 + 512 * i, ti = idx >> 1, hf = idx & 1; *(LAS u32x4*)(UL + (ti >> 4) * 528 + (ti & 15) * 32 + hf * 16) = pre[i]; }
            __syncthreads();
            if (bi < 3) S5_PRELOAD(b + 1)
            {
                float R = 0.f;
#pragma unroll 9
                for (int q = 0; q < 9; ++q) {
                    const int mt = q == 0 ? 0 : 9 - q;
                    f32x4 e0 = {0.f, 0.f, 0.f, 0.f}, e1 = {0.f, 0.f, 0.f, 0.f};
#pragma unroll
                    for (int kk = 0; kk < 8; kk += 2) {
                        const bf16x8 u0 = *(const LAS bf16x8*)(UL + (mt * 16 + m16) * 528 + kk * 64 + mq * 16), u1 = *(const LAS bf16x8*)(UL + (mt * 16 + m16) * 528 + (kk + 1) * 64 + mq * 16);
                        e0 = __builtin_amdgcn_mfma_f32_16x16x32_bf16(u0, Wb[kk], e0, 0, 0, 0); e1 = __builtin_amdgcn_mfma_f32_16x16x32_bf16(u1, Wb[kk + 1], e1, 0, 0, 0); }
                    float xin[4]; s5_scan2<1>(e0 + e1, R, kb, lane2, xin);
                    LAS char* xp = XL + (mt * 16 + 4 * mq) * 528 + (128 + 16 * w + m16) * 2;
#pragma unroll
                    for (int i = 0; i < 4; ++i) *(LAS unsigned short*)(xp + i * 528) = (unsigned short)cvt_pk_bf16(xin[i], xin[i]);
                }
            }
            {
                float R = 0.f;
#pragma unroll 9
                for (int mt = 0; mt < 9; ++mt) {
                    f32x4 e0 = {0.f, 0.f, 0.f, 0.f}, e1 = {0.f, 0.f, 0.f, 0.f};
#pragma unroll
                    for (int kk = 0; kk < 8; kk += 2) {
                        const bf16x8 u0 = *(const LAS bf16x8*)(UL + (mt * 16 + m16) * 528 + kk * 64 + mq * 16), u1 = *(const LAS bf16x8*)(UL + (mt * 16 + m16) * 528 + (kk + 1) * 64 + mq * 16);
                        e0 = __builtin_amdgcn_mfma_f32_16x16x32_bf16(u0, Wf[kk], e0, 0, 0, 0); e1 = __builtin_amdgcn_mfma_f32_16x16x32_bf16(u1, Wf[kk + 1], e1, 0, 0, 0); }
                    float xin[4]; s5_scan2<0>(e0 + e1, R, kf, lane2, xin);
                    LAS char* xp = XL + (mt * 16 + 4 * mq) * 528 + (16 * w + m16) * 2;
#pragma unroll
                    for (int i = 0; i < 4; ++i) *(LAS unsigned short*)(xp + i * 528) = (unsigned short)cvt_pk_bf16(xin[i], xin[i]);
                }
            }
            bf16x8 T3[2][16];
            { const bf16x8* tp = (const bf16x8*)(F.ws + WS_S5T3 + (size_t)it * 262144) + (size_t)(w * 32) * 64 + lane2;
#pragma unroll
              for (int tt = 0; tt < 2; ++tt)
#pragma unroll
                  for (int kk = 0; kk < 16; ++kk) T3[tt][kk] = tp[(tt * 16 + kk) * 64]; }
            __syncthreads();
#pragma unroll 1
            for (int mt = ctx_out ? 0 : 1; mt < 9; ++mt) {
                const LAS char* ub = UL + (mt * 16 + m16) * 528 + mq * 16;
                f32x4 y0 = {0.f, 0.f, 0.f, 0.f}, y1 = {0.f, 0.f, 0.f, 0.f};
#pragma unroll
                for (int kk = 0; kk < 8; ++kk) { const bf16x8 v = *(const LAS bf16x8*)(ub + kk * 64);
                    y0 = __builtin_amdgcn_mfma_f32_16x16x32_bf16(T3[0][kk], v, y0, 0, 0, 0); y1 = __builtin_amdgcn_mfma_f32_16x16x32_bf16(T3[1][kk], v, y1, 0, 0, 0); }
#pragma unroll
                for (int kk = 0; kk < 8; ++kk) { const bf16x8 v = *(const LAS bf16x8*)(ub + 144 * 528 + kk * 64);
                    y0 = __builtin_amdgcn_mfma_f32_16x16x32_bf16(T3[0][8 + kk], v, y0, 0, 0, 0); y1 = __builtin_amdgcn_mfma_f32_16x16x32_bf16(T3[1][8 + kk], v, y1, 0, 0, 0); }
                const size_t tok = (mt == 0 ? (size_t)(NLAT + b * 256 + m16 * 16) : (size_t)(b * 2048 + ((mt - 1) * 16 + m16) * 16)) + 2 * w;
#if GLU_FP8
                unsigned char* op = (unsigned char*)F.AO() + tok * D + g * 16 + mq * 4;
                *(unsigned*)op = pk4_fp8(gelu_tanh(y0[0]) * A8_SCALE, gelu_tanh(y0[1]) * A8_SCALE, gelu_tanh(y0[2]) * A8_SCALE, gelu_tanh(y0[3]) * A8_SCALE);
                *(unsigned*)(op + D) = pk4_fp8(gelu_tanh(y1[0]) * A8_SCALE, gelu_tanh(y1[1]) * A8_SCALE, gelu_tanh(y1[2]) * A8_SCALE, gelu_tanh(y1[3]) * A8_SCALE);
#else
                bf16_t* op = F.AO() + tok * D + g * 16 + mq * 4;
                u32x2 o0, o1; o0.x = cvt_pk_bf16(gelu_tanh(y0[0]), gelu_tanh(y0[1])); o0.y = cvt_pk_bf16(gelu_tanh(y0[2]), gelu_tanh(y0[3]));
                o1.x = cvt_pk_bf16(gelu_tanh(y1[0]), gelu_tanh(y1[1])); o1.y = cvt_pk_bf16(gelu_tanh(y1[2]), gelu_tanh(y1[3]));
                *(u32x2*)op = o0; *(u32x2*)(op + D) = o1;
#endif
            }
        }
#undef S5_PRELOAD
    }
    __syncthreads();
}

typedef const __attribute__((address_space(4))) Args* KArgs;
__device__ __forceinline__ Ctx make_ctx(int wave0, int blk0) {
    extern __shared__ __attribute__((aligned(16))) unsigned char lds_raw[];
    unsigned long long kp = (unsigned long long)(uintptr_t)(const void*)__builtin_amdgcn_kernarg_segment_ptr();
    asm volatile("" : "+s"(kp));
    KArgs A = (KArgs)(uintptr_t)kp;
    int lane; asm volatile("v_mbcnt_lo_u32_b32 %0, -1, 0\n\tv_mbcnt_hi_u32_b32 %0, -1, %0" : "=v"(lane));
    asm volatile("" : "+s"(wave0)); asm volatile("" : "+s"(blk0));
    Ctx F; F.in = (const float* const*)A->in; F.out = A->out; F.ws = A->ws; F.lds = (LAS unsigned char*)lds_raw;
    F.lane = lane; F.wave = wave0; F.tid = wave0 * 64 + lane; F.blk = blk0; F.G = gridDim.x;
    F.vcu = (F.G % 8 == 0) ? (F.blk % 8) * (F.G / 8) + F.blk / 8 : F.blk;
    F.split = (F.G % 128 == 0) ? 1 : 0;
    { const int x = F.blk & 7, li = F.blk >> 3, r = li & 15; F.conv = F.split && ((r % 5) == 4); const int below = (li >> 4) * 3 + r / 5;
      F.cblk = (li - below) * 8 + x; F.cG = F.G - (F.G >> 4) * 3; F.vblk = below * 8 + x; F.vG = (F.G >> 4) * 3; }
    return F;
}
#define MKCTX() make_ctx(wave0, blk0)
__device__ __forceinline__ void ph_prologue(int wave0, int blk0) { const Ctx F = MKCTX(); p_prologue(F); }
__device__ __forceinline__ void ph_R(int layer, int wave0, int blk0) { layer = __builtin_amdgcn_readfirstlane(layer); const Ctx F = MKCTX(); p_rows_R(F, layer); }
#define CONV_COUNT(F) ((CV_GU + CV_D + (F).vG - 1 - (F).vblk) / (F).vG)
__device__ __forceinline__ void ph_qkv(int layer, int wave0, int blk0) { layer = __builtin_amdgcn_readfirstlane(layer); const Ctx F = MKCTX(); const int j = layer >> 1;
    const bool sp0 = F.split && layer == 0;
    if (sp0 && F.conv) { const int cnt = CONV_COUNT(F); p_convert_fp8(F, F.vblk, F.vG, 0, cnt * 22 / 100); return; }
    ProbQKV P; P.A = F.H(); P.Bt = (const bf16_t*)(F.ws + WS_WQKV) + (size_t)j * 3072 * 1024; P.O = F.QKV(); P.rope = (const float*)(F.ws + WS_ROPE);
    P.ord.init(144, 12, sp0 ? F.cG : F.G, sp0 ? F.cblk : F.blk); pg8::gemm_phase(F.lds + LDS_SCR, P, F.tid); }
__device__ __forceinline__ void ph_attn(int layer, int wave0, int blk0) { layer = __builtin_amdgcn_readfirstlane(layer); const Ctx F = MKCTX();
    const bool sp0 = F.split && layer == 0;
    if (sp0 && F.conv) { const int cnt = CONV_COUNT(F); p_convert_fp8(F, F.vblk, F.vG, cnt * 22 / 100, cnt * 88 / 100); return; }
    const int Gc = sp0 ? F.cG : F.G, vc = sp0 ? (F.cblk & 7) * (F.cG >> 3) + (F.cblk >> 3) : F.vcu;
    p_attention(F, layer >> 1, Gc, vc); }
__device__ __forceinline__ void ph_wo(int layer, int wave0, int blk0) { layer = __builtin_amdgcn_readfirstlane(layer); const Ctx F = MKCTX(); const int j = layer >> 1;
    const bool sp0 = F.split && layer == 0;
    if (sp0 && F.conv) { const int cnt = CONV_COUNT(F); p_convert_fp8(F, F.vblk, F.vG, cnt * 88 / 100, cnt); return; }
    ProbResid<false> P; P.A = (const unsigned char*)F.AO(); P.Bt = F.ws + WS_WO + (size_t)j * 1024 * 1024 * (WO_FP8 ? 1 : 2); P.X = F.XB(); P.Xlat = F.in[0]; P.Xctx = F.in[2]; P.in_f32 = (layer == 0); P.gate = F.mod() + (size_t)layer * 17 * NMOD + 2 * D;
    P.ord.init(144, 4, sp0 ? F.cG : F.G, sp0 ? F.cblk : F.blk); if constexpr (WO_FP8) pg8::gemm_phase8(F.lds + LDS_SCR, P, F.tid); else pg8::gemm_phase(F.lds + LDS_SCR, P, F.tid); }
__device__ __forceinline__ void ph_scan(int layer, int wave0, int blk0) { layer = __builtin_amdgcn_readfirstlane(layer); const Ctx F = MKCTX(); p_s5ssd(F, layer >> 1, layer < 3); }
__device__ __forceinline__ void ph_glu(int layer, int wave0, int blk0) { layer = __builtin_amdgcn_readfirstlane(layer); const Ctx F = MKCTX(); const int j = layer >> 1;
    ProbResid<true> P; P.A = (const unsigned char*)F.AO(); P.Bt = F.ws + WS_WGLU + (size_t)j * 2048 * 1024 * (GLU_FP8 ? 1 : 2); P.X = F.XB(); P.Xlat = F.in[0]; P.Xctx = F.in[2]; P.in_f32 = false; P.gate = F.mod() + (size_t)layer * 17 * NMOD + 2 * D;
    P.ord.init(layer < 3 ? 144 : 128, 8, F.G, F.blk); if constexpr (GLU_FP8) pg8::gemm_phase8(F.lds + LDS_SCR, P, F.tid); else pg8::gemm_phase(F.lds + LDS_SCR, P, F.tid); }
__device__ __forceinline__ void ph_m1(int layer, int wave0, int blk0) { layer = __builtin_amdgcn_readfirstlane(layer); const Ctx F = MKCTX(); p_rows_M1(F, layer); }
__device__ __forceinline__ void ph_topk(int layer, int wave0, int blk0) { layer = __builtin_amdgcn_readfirstlane(layer); const Ctx F = MKCTX(); p_topk(F, layer); }
__device__ __forceinline__ void ph_moe1(int layer, int wave0, int blk0) { layer = __builtin_amdgcn_readfirstlane(layer); const Ctx F = MKCTX();
    ProbMoe1 P; P.A = F.H2Q(); P.Bt = F.ws + WS_WGU + (size_t)layer * 16 * 4096 * 1024; P.O = (void*)(F.ws + WS_BIG); P.midx = F.MIDX();
    P.ord.init(layer < 3 ? 18 : 16, 16, F.G, F.blk); pg8::gemm_phase8(F.lds + LDS_SCR, P, F.tid); }
__device__ __forceinline__ void ph_moe2(int layer, int wave0, int blk0) { layer = __builtin_amdgcn_readfirstlane(layer); const Ctx F = MKCTX();
    ProbMoe2 P; P.A = (const void*)(F.ws + WS_BIG); P.O = F.Y();
#if MOE2_FP8
    P.Bt = (const void*)(F.ws + WS_WD + (size_t)layer * 16 * 1024 * 2048);
    P.ord.init(layer < 3 ? 18 : 16, 4, F.G, F.blk); pg8::gemm_phase8(F.lds + LDS_SCR, P, F.tid);
    if (F.G == 256 && layer < 2 && (F.blk >> 3) >= 16) { const int ii = ((F.blk >> 3) - 16) * 8 + (F.blk & 7); p_s5tables(F, layer * 128 + ii, 128, layer * 128 + 128); }
#else
    P.Bt = (const void*)((const bf16_t*)(F.ws + WS_WD) + (size_t)layer * 16 * 1024 * 2048);
    P.ord.init(layer < 3 ? 18 : 16, 4, F.G, F.blk); pg8::gemm_phase(F.lds + LDS_SCR, P, F.tid);
#endif
}

constexpr int NPH = 34;
__global__ void __launch_bounds__(512, 2) mk_fwd(Args args) {
    extern __shared__ __attribute__((aligned(16))) unsigned char lds_raw[];
    const int lo = args.ph_lo, hi = args.ph_hi;
    const int wave0 = __builtin_amdgcn_readfirstlane(threadIdx.x >> 6), blk0 = __builtin_amdgcn_readfirstlane(blockIdx.x);
#if ONE_LAUNCH
    if (threadIdx.x < 4) ((LAS unsigned*)lds_raw)[threadIdx.x] = 0u;
    __syncthreads();
    XcdBarrier bar = xcd_barrier_post((unsigned*)(args.ws + WS_CTL), (volatile LAS unsigned*)lds_raw);
#define GRID_BAR() xcd_barrier(bar)
#else
#define GRID_BAR() do { } while (0)
#endif
#ifndef PHM
#define PHM 0xFFFF
#endif
#define PHS(b) ((PHM >> (b)) & 1)
#define IN(k) (lo <= (k) && (k) < hi)
#define SEAM(k) do { if (IN((k) + 1)) GRID_BAR(); } while (0)
    if (PHS(0) && IN(0)) { ph_prologue(wave0, blk0); SEAM(0); }
    for (int layer = 0; layer < 4; ++layer) {
        const int pb = 1 + 8 * layer;
        if (PHS(1) && IN(pb + 0)) { ph_R(layer, wave0, blk0); SEAM(pb + 0); }
        if ((layer & 1) == 0) {
            if (PHS(2) && IN(pb + 1)) { ph_qkv(layer, wave0, blk0); SEAM(pb + 1); }
            if (PHS(3) && IN(pb + 2)) { ph_attn(layer, wave0, blk0); SEAM(pb + 2); }
            if (PHS(4) && IN(pb + 3)) { ph_wo(layer, wave0, blk0); SEAM(pb + 3); }
        } else {
            if (PHS(5) && IN(pb + 1)) { ph_scan(layer, wave0, blk0); SEAM(pb + 1); }
            if (PHS(6) && IN(pb + 2)) { ph_glu(layer, wave0, blk0); SEAM(pb + 3); }
        }
        if (PHS(7) && IN(pb + 4)) { ph_m1(layer, wave0, blk0); SEAM(pb + 4); }
        if (PHS(8) && IN(pb + 5)) { ph_topk(layer, wave0, blk0); SEAM(pb + 5); }
        if (PHS(9) && IN(pb + 6)) { ph_moe1(layer, wave0, blk0); SEAM(pb + 6); }
        if (PHS(10) && IN(pb + 7)) { ph_moe2(layer, wave0, blk0); SEAM(pb + 7); }
    }
    if (PHS(1) && IN(33)) ph_R(4, wave0, blk0);
#undef IN
#undef SEAM
}

extern "C" void kernel_launch(void* const* d_in, const int* in_sizes, int n_in, void* d_out, int out_size, void* d_ws, size_t ws_size, hipStream_t stream) {
    static int grid = 0;
    if (grid == 0) {
        if (n_in != 31 || out_size != NLAT * D || ws_size < WS_END) { fprintf(stderr, "kernel_launch: unexpected shapes: n_in %d out %d ws %zu (need %zu)\n", n_in, out_size, ws_size, (size_t)WS_END); grid = -1; return; }
        int dev = 0, cus = 0, per_cu = 0;
        if (hipGetDevice(&dev) != hipSuccess || hipDeviceGetAttribute(&cus, hipDeviceAttributeMultiprocessorCount, dev) != hipSuccess) { grid = -1; return; }
        if (hipFuncSetAttribute((const void*)mk_fwd, hipFuncAttributeMaxDynamicSharedMemorySize, LDS_BYTES) != hipSuccess) { fprintf(stderr, "kernel_launch: hipFuncSetAttribute failed\n"); grid = -1; return; }
        if (hipOccupancyMaxActiveBlocksPerMultiprocessor(&per_cu, (const void*)mk_fwd, 512, LDS_BYTES) != hipSuccess || per_cu < 1) { fprintf(stderr, "kernel_launch: occupancy query says %d\n", per_cu); }
        (void)hipGetLastError();
        grid = cus;
    }
    if (grid < 0) return;
    (void)in_sizes;
    Args a{};
    for (int i = 0; i < 31; ++i) a.in[i] = (const float*)d_in[i];
    a.out = (float*)d_out; a.ws = (unsigned char*)d_ws;
#if ONE_LAUNCH
    (void)hipMemsetAsync((char*)d_ws + WS_CTL, 0, 65536, stream);
    a.ph_lo = 0; a.ph_hi = NPH;
    hipLaunchKernelGGL(mk_fwd, dim3(grid), dim3(512), LDS_BYTES, stream, a);
#else
    for (int ph = 0; ph < NPH; ++ph) {
        if (ph >= 1 && ph <= 32) { const int layer = (ph - 1) / 8, slot = (ph - 1) % 8; if ((layer & 1) == 1 && slot == 3) continue; }
        a.ph_lo = ph; a.ph_hi = ph + 1;
        hipLaunchKernelGGL(mk_fwd, dim3(grid), dim3(512), LDS_BYTES, stream, a);
    }
#endif
    const hipError_t le = hipPeekAtLastError();
    if (le != hipSuccess) fprintf(stderr, "kernel_launch: launch failed: %s\n", hipGetErrorName(le));
}
```
